# Optimizing an MI355X kernel written in HIP

```python
import math
import jax
import jax.numpy as jnp
from jax import lax
import numpy as np

D_MODEL = 2048
BATCH = 4
SEQ = 2048
DEPTH = 2

HEAD_DIM = 128
ATTN_WIDTH = D_MODEL // 2
ATTN_HEADS = ATTN_WIDTH // HEAD_DIM
MOBA_BLOCK = 256
MOBA_TOPK = 3
Q_CHUNK = 64
ROPE_THETA = 10000.0
SSM_WIDTH = D_MODEL // 4
SSM_HEAD_DIM = 64
SSM_HEADS = SSM_WIDTH // SSM_HEAD_DIM
SSM_GROUPS = 2
SSM_STATE = 128
SSM_CONV = 4
SSM_CHUNK = 128
SSM_CONV_DIM = SSM_WIDTH + 2 * SSM_GROUPS * SSM_STATE
CONV_WIDTH = D_MODEL // 4
CONV_SIZE = 31
MIX_WIDTH = ATTN_WIDTH + SSM_WIDTH + CONV_WIDTH
IN_SPLITS = (ATTN_WIDTH, ATTN_WIDTH, ATTN_WIDTH, SSM_WIDTH, SSM_CONV_DIM, SSM_HEADS, 2 * CONV_WIDTH)
IN_DIM = sum(IN_SPLITS)
D_FF = 7 * D_MODEL // 2
N_EXPERTS = 8
TOP_K = 2
N_DENSE = (DEPTH + 1) // 2
N_MOE = DEPTH // 2
EPS = 1e-5

kernel_name = 'hybrid_moba_ssd_conformer_moe'


def rms_norm(x, w):
    xf = x.astype(jnp.float32)
    y = xf * lax.rsqrt(jnp.mean(xf * xf, axis=-1, keepdims=True) + EPS)
    return (y * w.astype(jnp.float32)).astype(x.dtype)


def rope_tables(seqlen):
    pos = jnp.arange(seqlen, dtype=jnp.float32)
    inv_freq = 1.0 / (ROPE_THETA ** (jnp.arange(0, HEAD_DIM, 2, dtype=jnp.float32) / HEAD_DIM))
    ang = pos[:, None] * inv_freq[None, :]
    return jnp.cos(ang), jnp.sin(ang)


def apply_rope(x, cos, sin):
    xf = x.astype(jnp.float32)
    half = HEAD_DIM // 2
    x1, x2 = xf[..., :half], xf[..., half:]
    out = jnp.concatenate([x1 * cos - x2 * sin, x2 * cos + x1 * sin], axis=-1)
    return out.astype(x.dtype)


def causal_depthwise_conv(x, w, b):
    k = w.shape[0]
    y = lax.conv_general_dilated(
        x, w[:, None, :].astype(x.dtype), window_strides=(1,), padding=((k - 1, 0),),
        dimension_numbers=('NWC', 'WIO', 'NWC'), feature_group_count=x.shape[-1])
    return y + b.astype(x.dtype)


def moba_attention(q, k, v):
    bsz, nh, seqlen, hd = q.shape
    s_pad = -(-seqlen // MOBA_BLOCK) * MOBA_BLOCK
    pad = ((0, 0), (0, 0), (0, s_pad - seqlen), (0, 0))
    q = jnp.pad(q, pad)
    k = jnp.pad(k, pad)
    v = jnp.pad(v, pad)
    nb = s_pad // MOBA_BLOCK
    topk = min(MOBA_TOPK, nb)
    k_blocks = k.reshape(bsz, nh, nb, MOBA_BLOCK, hd)
    v_blocks = v.reshape(bsz, nh, nb, MOBA_BLOCK, hd)
    k_mean = jnp.mean(k_blocks.astype(jnp.float32), axis=3)
    scale = HEAD_DIM ** -0.5
    bi = jnp.arange(bsz)[:, None, None, None]
    hi = jnp.arange(nh)[None, :, None, None]

    def one_chunk(i):
        start = i * Q_CHUNK
        blk = start // MOBA_BLOCK
        qc = lax.dynamic_slice_in_dim(q, start, Q_CHUNK, axis=2)
        k_own = lax.dynamic_slice_in_dim(k, blk * MOBA_BLOCK, MOBA_BLOCK, axis=2)
        v_own = lax.dynamic_slice_in_dim(v, blk * MOBA_BLOCK, MOBA_BLOCK, axis=2)
        gate = jnp.einsum('bhqd,bhnd->bhqn', qc.astype(jnp.float32), k_mean)
        gate = jnp.where(jnp.arange(nb) < blk, gate, -jnp.inf)
        _, idx = lax.top_k(gate, topk)
        sel_valid = idx < blk
        k_sel = k_blocks[bi, hi, idx]
        v_sel = v_blocks[bi, hi, idx]
        s_own = jnp.einsum('bhqd,bhkd->bhqk', qc, k_own).astype(jnp.float32) * scale
        qpos = start + jnp.arange(Q_CHUNK)
        kpos = blk * MOBA_BLOCK + jnp.arange(MOBA_BLOCK)
        s_own = jnp.where(kpos[None, :] <= qpos[:, None], s_own, -jnp.inf)
        s_sel = jnp.einsum('bhqd,bhqjkd->bhqjk', qc, k_sel).astype(jnp.float32) * scale
        s_sel = jnp.where(sel_valid[..., None], s_sel, -jnp.inf)
        s = jnp.concatenate([s_own, s_sel.reshape(bsz, nh, Q_CHUNK, topk * MOBA_BLOCK)], axis=-1)
        p = jax.nn.softmax(s, axis=-1).astype(v.dtype)
        p_own = p[..., :MOBA_BLOCK]
        p_sel = p[..., MOBA_BLOCK:].reshape(bsz, nh, Q_CHUNK, topk, MOBA_BLOCK)
        return (jnp.einsum('bhqk,bhkd->bhqd', p_own, v_own)
                + jnp.einsum('bhqjk,bhqjkd->bhqd', p_sel, v_sel))

    out = lax.map(one_chunk, jnp.arange(s_pad // Q_CHUNK))
    out = out.transpose(1, 2, 0, 3, 4).reshape(bsz, nh, s_pad, hd)
    return out[:, :, :seqlen]


def ssd_chunked(x, dt, a, b_in, c_in):
    bsz, seqlen, nh, hp = x.shape
    ng, ns = b_in.shape[2], b_in.shape[3]
    hg = nh // ng
    nc = seqlen // SSM_CHUNK
    cl = SSM_CHUNK
    xr = (x * dt[..., None]).reshape(bsz, nc, cl, ng, hg, hp)
    la = (dt * a).reshape(bsz, nc, cl, ng, hg)
    la_cum = jnp.cumsum(la, axis=2)
    br = b_in.reshape(bsz, nc, cl, ng, ns)
    cr = c_in.reshape(bsz, nc, cl, ng, ns)
    causal = jnp.tril(jnp.ones((cl, cl), dtype=bool))
    seg = la_cum[:, :, :, None] - la_cum[:, :, None, :]
    decay = jnp.exp(jnp.where(causal[None, None, :, :, None, None], seg, -jnp.inf))
    cb = jnp.einsum('bctgn,bcsgn->bctsg', cr, br)
    y_diag = jnp.einsum('bctsgh,bcsghp->bctghp', cb[..., None] * decay, xr)
    decay_to_end = jnp.exp(la_cum[:, :, -1:] - la_cum)
    chunk_states = jnp.einsum('bcsgn,bcsghp->bcghpn', br, xr * decay_to_end[..., None])
    chunk_decay = jnp.exp(la_cum[:, :, -1])

    def step(state, inp):
        st, dec = inp
        return state * dec[..., None, None] + st, state

    init = jnp.zeros((bsz, ng, hg, hp, ns), x.dtype)
    _, prev = lax.scan(step, init, (jnp.moveaxis(chunk_states, 1, 0), jnp.moveaxis(chunk_decay, 1, 0)))
    prev = jnp.moveaxis(prev, 0, 1)
    y_off = jnp.einsum('bctgn,bcghpn->bctghp', cr, prev) * jnp.exp(la_cum)[..., None]
    return (y_diag + y_off).reshape(bsz, seqlen, nh, hp)


def mamba2_mixer(z, xbc, dt_raw, conv_w, conv_b, dt_bias, a_log, d_skip, norm_w):
    bsz, seqlen, _ = z.shape
    xbc = jax.nn.silu(causal_depthwise_conv(xbc, conv_w, conv_b))
    gn = SSM_GROUPS * SSM_STATE
    xs = xbc[..., :SSM_WIDTH].astype(jnp.float32).reshape(bsz, seqlen, SSM_HEADS, SSM_HEAD_DIM)
    bm = xbc[..., SSM_WIDTH:SSM_WIDTH + gn].astype(jnp.float32).reshape(bsz, seqlen, SSM_GROUPS, SSM_STATE)
    cm = xbc[..., SSM_WIDTH + gn:].astype(jnp.float32).reshape(bsz, seqlen, SSM_GROUPS, SSM_STATE)
    dt = jax.nn.softplus(dt_raw.astype(jnp.float32) + dt_bias.astype(jnp.float32))
    a = -jnp.exp(a_log.astype(jnp.float32))
    y = ssd_chunked(xs, dt, a, bm, cm) + d_skip.astype(jnp.float32)[:, None] * xs
    y = y.reshape(bsz, seqlen, SSM_WIDTH) * jax.nn.silu(z.astype(jnp.float32))
    yg = y.reshape(bsz, seqlen, SSM_GROUPS, SSM_WIDTH // SSM_GROUPS)
    yg = yg * lax.rsqrt(jnp.mean(yg * yg, axis=-1, keepdims=True) + EPS)
    y = yg.reshape(bsz, seqlen, SSM_WIDTH) * norm_w.astype(jnp.float32)
    return y.astype(z.dtype)


def conformer_conv(u, conv_w, conv_b, ln_w, ln_b):
    a, g = u[..., :CONV_WIDTH], u[..., CONV_WIDTH:]
    hcv = causal_depthwise_conv(a * jax.nn.sigmoid(g), conv_w, conv_b)
    hf = hcv.astype(jnp.float32)
    mu = jnp.mean(hf, axis=-1, keepdims=True)
    var = jnp.mean(jnp.square(hf - mu), axis=-1, keepdims=True)
    hf = (hf - mu) * lax.rsqrt(var + EPS) * ln_w.astype(jnp.float32) + ln_b.astype(jnp.float32)
    return jax.nn.silu(hf).astype(u.dtype)


def swiglu(h, w_gate, w_up, w_down):
    g = jnp.einsum('bsd,df->bsf', h, w_gate)
    u = jnp.einsum('bsd,df->bsf', h, w_up)
    return jnp.einsum('bsf,fd->bsd', jax.nn.silu(g) * u, w_down)


def moe_swiglu(h, w_router, w_gate, w_up, w_down):
    logits = jnp.einsum('bsd,de->bse', h, w_router).astype(jnp.float32)
    top_vals, top_idx = lax.top_k(logits, TOP_K)
    gates = jax.nn.softmax(top_vals, axis=-1)
    combine = jnp.sum(jax.nn.one_hot(top_idx, N_EXPERTS, dtype=jnp.float32) * gates[..., None], axis=-2)
    out = jnp.zeros_like(h)
    for e in range(N_EXPERTS):
        out = out + combine[..., e:e + 1].astype(h.dtype) * swiglu(h, w_gate[e], w_up[e], w_down[e])
    return out


def setup_inputs(seed: int = 0) -> dict:
    key = jax.random.key(seed)
    ks = jax.random.split(key, 24)
    f32 = jnp.float32
    L = DEPTH

    def nrm(k, shape, scale):
        return jax.random.normal(k, shape, f32) * scale

    dt0 = jnp.exp(jax.random.uniform(ks[5], (L, SSM_HEADS), f32, math.log(1e-3), math.log(1e-1)))
    return {
        'x': nrm(ks[0], (BATCH, SEQ, D_MODEL), 1.0),
        'norm_mix': 1.0 + nrm(ks[1], (L, D_MODEL), 0.01),
        'w_in': nrm(ks[2], (L, D_MODEL, IN_DIM), D_MODEL ** -0.5),
        'ssm_conv_w': nrm(ks[3], (L, SSM_CONV, SSM_CONV_DIM), SSM_CONV ** -0.5),
        'ssm_conv_b': nrm(ks[4], (L, SSM_CONV_DIM), 0.01),
        'ssm_dt_bias': dt0 + jnp.log(-jnp.expm1(-dt0)),
        'ssm_a_log': jnp.log(jax.random.uniform(ks[6], (L, SSM_HEADS), f32, 1.0, 16.0)),
        'ssm_d': 1.0 + nrm(ks[7], (L, SSM_HEADS), 0.1),
        'ssm_norm_w': 1.0 + nrm(ks[8], (L, SSM_WIDTH), 0.01),
        'cf_conv_w': nrm(ks[9], (L, CONV_SIZE, CONV_WIDTH), CONV_SIZE ** -0.5),
        'cf_conv_b': nrm(ks[10], (L, CONV_WIDTH), 0.01),
        'cf_ln_w': 1.0 + nrm(ks[11], (L, CONV_WIDTH), 0.01),
        'cf_ln_b': nrm(ks[12], (L, CONV_WIDTH), 0.01),
        'w_out': nrm(ks[13], (L, MIX_WIDTH, D_MODEL), MIX_WIDTH ** -0.5),
        'norm_ffn': 1.0 + nrm(ks[14], (L, D_MODEL), 0.01),
        'ffn_w_gate': nrm(ks[15], (N_DENSE, D_MODEL, D_FF), D_MODEL ** -0.5),
        'ffn_w_up': nrm(ks[16], (N_DENSE, D_MODEL, D_FF), D_MODEL ** -0.5),
        'ffn_w_down': nrm(ks[17], (N_DENSE, D_FF, D_MODEL), D_FF ** -0.5),
        'moe_router': nrm(ks[18], (N_MOE, D_MODEL, N_EXPERTS), D_MODEL ** -0.5),
        'moe_w_gate': nrm(ks[19], (N_MOE, N_EXPERTS, D_MODEL, D_FF), D_MODEL ** -0.5),
        'moe_w_up': nrm(ks[20], (N_MOE, N_EXPERTS, D_MODEL, D_FF), D_MODEL ** -0.5),
        'moe_w_down': nrm(ks[21], (N_MOE, N_EXPERTS, D_FF, D_MODEL), D_FF ** -0.5),
        'norm_final': 1.0 + nrm(ks[22], (D_MODEL,), 0.01),
    }


def reference(x, norm_mix, w_in, ssm_conv_w, ssm_conv_b, ssm_dt_bias, ssm_a_log, ssm_d, ssm_norm_w,
              cf_conv_w, cf_conv_b, cf_ln_w, cf_ln_b, w_out, norm_ffn,
              ffn_w_gate, ffn_w_up, ffn_w_down, moe_router, moe_w_gate, moe_w_up, moe_w_down,
              norm_final):
    bsz, seqlen, _ = x.shape
    cos, sin = rope_tables(seqlen)
    split_at = np.cumsum(IN_SPLITS)[:-1].tolist()

    def to_heads(t):
        return t.reshape(bsz, seqlen, ATTN_HEADS, HEAD_DIM).transpose(0, 2, 1, 3)

    h = x
    for layer in range(DEPTH):
        hn = rms_norm(h, norm_mix[layer])
        proj = jnp.einsum('bsd,de->bse', hn, w_in[layer])
        q, k, v, z, xbc, dt_raw, glu_in = jnp.split(proj, split_at, axis=-1)
        q = apply_rope(to_heads(q), cos, sin)
        k = apply_rope(to_heads(k), cos, sin)
        attn = moba_attention(q, k, to_heads(v))
        attn = attn.transpose(0, 2, 1, 3).reshape(bsz, seqlen, ATTN_WIDTH)
        ssm = mamba2_mixer(z, xbc, dt_raw, ssm_conv_w[layer], ssm_conv_b[layer], ssm_dt_bias[layer],
                           ssm_a_log[layer], ssm_d[layer], ssm_norm_w[layer])
        conv = conformer_conv(glu_in, cf_conv_w[layer], cf_conv_b[layer], cf_ln_w[layer], cf_ln_b[layer])
        mixed = jnp.concatenate([attn, ssm, conv], axis=-1)
        h = h + jnp.einsum('bsm,md->bsd', mixed, w_out[layer])
        hn = rms_norm(h, norm_ffn[layer])
        if layer % 2 == 0:
            i = layer // 2
            h = h + swiglu(hn, ffn_w_gate[i], ffn_w_up[i], ffn_w_down[i])
        else:
            i = layer // 2
            h = h + moe_swiglu(hn, moe_router[i], moe_w_gate[i], moe_w_up[i], moe_w_down[i])
    return rms_norm(h, norm_final)
```

```cpp
#include <hip/hip_runtime.h>
#include <cstdio>
#include <cstdint>

#ifndef PROBE_MASK
#define PROBE_MASK 0u
#endif
#define PROBE_SUB 0
#ifndef MK_PER_PHASE
#define MK_PER_PHASE 0
#endif

constexpr int DM = 2048, NBATCH = 4, SEQ = 2048, M = NBATCH * SEQ;
constexpr int IN_DIM = 5640, NP = 5632;
constexpr int DFF = 7168, NE = 8, MPMAX = 72 * 256;
constexpr int NWAVES = 8;
constexpr float EPS = 1e-5f;
constexpr int PC_Q = 0, PC_K = 1024, PC_V = 2048, PC_Z = 3072, PC_X = 3584, PC_G = 4608;

constexpr size_t MiB = 1u << 20;
constexpr size_t WS_CTL = 0, CTL_ZERO_BYTES = 32 * 1024;
constexpr size_t WS_ROPE = 1 * MiB;
constexpr size_t WS_SMALL = 2 * MiB;
constexpr size_t WS_WIN = 4 * MiB;
constexpr size_t WS_WOUT = WS_WIN + 45 * MiB;
constexpr size_t WS_WGU = WS_WOUT + 16 * MiB;
constexpr size_t WS_WGU8 = WS_WGU + 56 * MiB;
constexpr size_t WS_WDN = WS_WGU8 + 224 * MiB;
constexpr size_t WS_WDN8 = WS_WDN + 28 * MiB;
constexpr size_t WS_HA = WS_WDN8 + 112 * MiB;
constexpr size_t WS_HB = WS_HA + 64 * MiB;
constexpr size_t WS_HN = WS_HB + 64 * MiB;
constexpr size_t WS_P = WS_HN + 32 * MiB;
constexpr size_t WS_MIX = WS_P + 88 * MiB;
constexpr size_t WS_ACT = WS_MIX + 32 * MiB;
constexpr size_t WS_YT = WS_ACT + 16 * MiB;
constexpr size_t WS_ACT8 = WS_ACT + 112 * MiB;
constexpr size_t WS_XP8 = WS_ACT8 + 126 * MiB;
constexpr size_t WS_HN8 = WS_XP8 + 36 * MiB;
constexpr size_t WS_Y = WS_HN8 + 16 * MiB;
constexpr size_t WS_XC = WS_Y + 144 * MiB;
constexpr size_t WS_ST = WS_XC + 32 * MiB;
constexpr size_t WS_YZ = WS_ST + 16 * MiB;
constexpr size_t WS_END = WS_YZ + 16 * MiB;
static_assert(WS_END <= 1792 * MiB, "d_ws map must fit 4 x the largest input tensor (1792 MiB)");
constexpr size_t SM_DT = 0;
constexpr size_t SM_LAC = 256 * 1024;
constexpr size_t SM_DEC = 512 * 1024;
constexpr size_t SM_KMEAN = 520 * 1024;
constexpr size_t SM_TOKE = 656 * 1024;
constexpr size_t SM_TOKG = 688 * 1024;
constexpr size_t SM_POS = 752 * 1024;
constexpr size_t SM_WCNT = 816 * 1024;
constexpr size_t SM_BCNT = 880 * 1024;
constexpr size_t SM_ETOT = 888 * 1024;
constexpr size_t SM_NWC = 896 * 1024;
constexpr size_t SM_SS = 1024 * 1024;
constexpr int RS_OFF = 131072 + 4096;
constexpr int CW_BAR = 4096;
constexpr int RING_BYTES = 131072, MISC_OFF = 131072, SCHED_OFF = MISC_OFF + 256, LDS_BYTES = 147456;

namespace pg8 {
#define PG8_LAS __attribute__((address_space(3)))
#define PG8_GAS __attribute__((address_space(1)))
typedef unsigned short bf16_t;
typedef short bf16x8 __attribute__((ext_vector_type(8)));
typedef float f32x4 __attribute__((ext_vector_type(4)));
typedef unsigned u32x4 __attribute__((ext_vector_type(4)));
constexpr int BM = 256, BK = 64, HALF = 128, HTB = HALF * BK * 2, STAGE_BYTES = 8 * HTB, NXCD = 8, WGM = 8;

__host__ __device__ __forceinline__ int lds_byte(int r, int c) { const int st = (r >> 4) * 2 + (c >> 5), rr = r & 15, cc = c & 31, ob = rr * 64 + cc * 2; return st * 1024 + (ob ^ (((ob >> 9) & 1) << 5)); }
__host__ __device__ __forceinline__ void stage_rc(int b, int& R, int& C) { const int st = b / 1024, sb = b % 1024, swz = sb ^ (((sb >> 9) & 1) << 5); R = (st >> 1) * 16 + swz / 64; C = (st & 1) * 32 + (swz % 64) / 2; }
__host__ __device__ __forceinline__ int perm32(int rho) { const int n = rho >> 4, i = rho & 15; return 8 * (i >> 2) + 4 * n + (i & 3); }

struct Unit { int pm, pn, pnl, sk; __device__ __forceinline__ int kp() const { return sk & 0xff; } __device__ __forceinline__ int ks() const { return (sk >> 8) & 0xff; } __device__ __forceinline__ int tl() const { return (sk >> 16) - 1; } };
struct Gemm { const bf16_t* A; const bf16_t* Bt; int M, N, K; };

struct StaticOrder {
    int nM, nN, nwg, G, c;
    __device__ void init(int M, int N, int G_, int c_) { nM = M / BM; nN = N / BM; nwg = nM * nN; G = G_; c = c_; }
    __device__ __forceinline__ bool next(int i, Unit& u) const {
        const long L = (long)i * G + c; if (L >= nwg) return false;
        int wgid = (int)L; { const int q = nwg / NXCD, r = nwg % NXCD, xcd = wgid % NXCD, off = wgid / NXCD; wgid = (xcd < r ? xcd * (q + 1) : r * (q + 1) + (xcd - r) * q) + off; }
        const int nig = WGM * nN, gid = wgid / nig, fm = gid * WGM, gsz = (nM - fm) < WGM ? (nM - fm) : WGM;
        u.pm = fm + ((wgid % nig) % gsz); u.pn = (wgid % nig) / gsz; u.pnl = u.pn; u.sk = 0x100; return true;
    }
    __device__ __forceinline__ void a_ready(const Unit&) const {}
    __device__ __forceinline__ void done(const Unit&) const {}
};
struct GroupOrder {
    const PG8_LAS int* tb; int G, c, nwg;
    __device__ __forceinline__ bool next(int i, Unit& u) const {
        const long L = (long)i * G + c; if (L >= nwg) return false;
        const int nfull = tb[80], S = tb[81]; int kp = 0, tl = -1;
        int wgid = (int)L;
        if (wgid < nfull) { const int q = nfull / NXCD, r = nfull % NXCD, xcd = wgid % NXCD, off = wgid / NXCD; wgid = (xcd < r ? xcd * (q + 1) : r * (q + 1) + (xcd - r) * q) + off; }
        else { const int v = wgid - nfull; tl = v / S; kp = v - tl * S; wgid = nfull + tl; }
        const int ng = tb[0]; int g = 0;
        for (int k = 1; k < 8; ++k) if (k < ng && wgid >= tb[48 + k]) g = k;
        const int r = wgid - tb[48 + g], mt = tb[32 + g], pnl = r / mt, pm = tb[40 + g] + (r - pnl * mt);
        u.pm = __builtin_amdgcn_readfirstlane(pm); u.pnl = __builtin_amdgcn_readfirstlane(pnl); u.pn = __builtin_amdgcn_readfirstlane(tb[64 + g] + pnl);
        u.sk = __builtin_amdgcn_readfirstlane(kp | ((tl >= 0 ? S : 1) << 8) | ((tl + 1) << 16)); return true;
    }
    __device__ __forceinline__ void a_ready(const Unit&) const {}
    __device__ __forceinline__ void done(const Unit&) const {}
};

__device__ __forceinline__ float xrow_sum4(float v) {
    { const unsigned x = __builtin_bit_cast(unsigned, v); const auto r = __builtin_amdgcn_permlane32_swap(x, x, false, false); v = __builtin_bit_cast(float, (unsigned)r[0]) + __builtin_bit_cast(float, (unsigned)r[1]); }
    { const unsigned x = __builtin_bit_cast(unsigned, v); const auto r = __builtin_amdgcn_permlane16_swap(x, x, false, false); v = __builtin_bit_cast(float, (unsigned)r[0]) + __builtin_bit_cast(float, (unsigned)r[1]); }
    return v; }
__device__ __forceinline__ unsigned cvt_pk_bf16(float lo, float hi) { unsigned r; asm volatile("v_cvt_pk_bf16_f32 %0, %1, %2" : "=v"(r) : "v"(lo), "v"(hi)); return r; }

struct EpiInproj {
    static constexpr bool PERM = true, AFTER_DRAIN = false;
    bf16_t* O; int ldc; const float* rope; float qscale;
    const PG8_LAS unsigned char* rsb;
    __device__ __forceinline__ void operator()(const f32x4 (&acc)[2][2][4][2], const Unit& u, int wr, int wc, int fr, int fq) const {
        const int row0 = u.pm * BM + wr * 64 + fr;
        const PG8_LAS float* rst = nullptr;
        if (rsb) { const PG8_LAS int* pml = (const PG8_LAS int*)(rsb - 16); const int sl = pml[0] == u.pm ? 0 : (pml[1] == u.pm ? 1 : (pml[2] == u.pm ? 2 : 3));
            rst = (const PG8_LAS float*)rsb + sl * 256 + wr * 64 + fr; }
        if (u.pn == 22) {
            if (wc == 0 && fq == 0) {
                unsigned char* wsb = (unsigned char*)O - WS_P; const float* bia = (const float*)(wsb + WS_SMALL + SM_NWC) + 2 * DM; float* dto = (float*)(wsb + WS_SMALL + SM_DT);
                const f32x4 b0 = *(const f32x4*)bia, b1 = *(const f32x4*)(bia + 4);
#pragma unroll
                for (int ai = 0; ai < 2; ++ai)
#pragma unroll
                    for (int m = 0; m < 4; ++m) { const float r = rst[ai * HALF + m * 16]; f32x4 x0 = acc[ai][0][m][0] * r + b0, x1 = acc[ai][0][m][1] * r + b1;
#pragma unroll
                        for (int j = 0; j < 4; ++j) { x0[j] = fmaxf(x0[j], 0.f) + 0.6931471805599453f * __builtin_amdgcn_logf(1.0f + __builtin_amdgcn_exp2f(-1.4426950408889634f * __builtin_fabsf(x0[j])));
                                                      x1[j] = fmaxf(x1[j], 0.f) + 0.6931471805599453f * __builtin_amdgcn_logf(1.0f + __builtin_amdgcn_exp2f(-1.4426950408889634f * __builtin_fabsf(x1[j]))); }
                        float* dp = dto + (size_t)(row0 + ai * HALF + m * 16) * 8; *(f32x4*)dp = x0; *(f32x4*)(dp + 4) = x1; }
            }
            return;
        }
        if (u.pn < 8) {
            const int part = u.pn >> 2, pl = u.pn & 3, head = 2 * pl + (wc >> 1), dlo = (wc & 1) * 32 + 8 * fq;
            const float sc0 = part == 0 ? qscale : 1.0f;
            const PG8_GAS float* grope = (const PG8_GAS float*)rope; PG8_GAS bf16_t* gO = (PG8_GAS bf16_t*)O;
            f32x4 rq[2][4];
#define PG8_RP_LD(G, D) do { const int pos_ = (row0 + ((G) >> 2) * HALF + ((G) & 3) * 16) & 2047; _Pragma("unroll") for (int q_ = 0; q_ < 4; ++q_) D[q_] = *(const PG8_GAS f32x4*)(grope + ((size_t)pos_ * 64 + dlo) * 2 + 4 * q_); } while (0)
            PG8_RP_LD(0, rq[0]);
#pragma unroll
            for (int g = 0; g < 8; ++g) { const int ai = g >> 2, m = g & 3;
                {
                    if (g + 1 < 8) PG8_RP_LD(g + 1, rq[(g + 1) & 1]);
                    const float sc = rsb ? sc0 * rst[ai * HALF + m * 16] : sc0;
                    const int row = row0 + ai * HALF + m * 16;
                    u32x4 w1, w2; unsigned o1[4], o2[4];
#pragma unroll
                    for (int n = 0; n < 2; ++n) {
                        const f32x4 cs0 = rq[g & 1][2 * n], cs1 = rq[g & 1][2 * n + 1];
                        const f32x4 x1 = acc[ai][0][m][n], x2 = acc[ai][1][m][n];
                        const float a0 = (x1[0] * cs0[0] - x2[0] * cs0[1]) * sc, a1 = (x1[1] * cs0[2] - x2[1] * cs0[3]) * sc;
                        const float a2 = (x1[2] * cs1[0] - x2[2] * cs1[1]) * sc, a3 = (x1[3] * cs1[2] - x2[3] * cs1[3]) * sc;
                        const float b0 = (x2[0] * cs0[0] + x1[0] * cs0[1]) * sc, b1 = (x2[1] * cs0[2] + x1[1] * cs0[3]) * sc;
                        const float b2 = (x2[2] * cs1[0] + x1[2] * cs1[1]) * sc, b3 = (x2[3] * cs1[2] + x1[3] * cs1[3]) * sc;
                        o1[2 * n] = cvt_pk_bf16(a0, a1); o1[2 * n + 1] = cvt_pk_bf16(a2, a3);
                        o2[2 * n] = cvt_pk_bf16(b0, b1); o2[2 * n + 1] = cvt_pk_bf16(b2, b3);
                    }
                    w1.x = o1[0]; w1.y = o1[1]; w1.z = o1[2]; w1.w = o1[3]; w2.x = o2[0]; w2.y = o2[1]; w2.z = o2[2]; w2.w = o2[3];
                    PG8_GAS bf16_t* rowp = gO + (size_t)row * ldc + part * 1024 + head * 128 + dlo;
                    *(PG8_GAS u32x4*)rowp = w1; *(PG8_GAS u32x4*)(rowp + 64) = w2;
                }
            }
        } else {
            const int col0 = u.pn * BM + wc * 32 + 8 * fq;
#pragma unroll
            for (int ai = 0; ai < 2; ++ai)
#pragma unroll
                for (int m = 0; m < 4; ++m) { PG8_GAS bf16_t* rowp = (PG8_GAS bf16_t*)O + (size_t)(row0 + ai * HALF + m * 16) * ldc + col0; const float r = rsb ? rst[ai * HALF + m * 16] : 1.0f;
#pragma unroll
                    for (int bj = 0; bj < 2; ++bj) { const f32x4 v0 = acc[ai][bj][m][0] * r, v1 = acc[ai][bj][m][1] * r;
                        u32x4 w; w.x = cvt_pk_bf16(v0[0], v0[1]); w.y = cvt_pk_bf16(v0[2], v0[3]); w.z = cvt_pk_bf16(v1[0], v1[1]); w.w = cvt_pk_bf16(v1[2], v1[3]);
                        *(PG8_GAS u32x4*)(rowp + bj * HALF) = w; } }
        }
    }
};
struct EpiSwiglu {
    static constexpr bool PERM = true, AFTER_DRAIN = false;
    bf16_t* O; int ldc;
    __device__ __forceinline__ void operator()(const f32x4 (&acc)[2][2][4][2], const Unit& u, int wr, int wc, int fr, int fq) const {
        const int row0 = u.pm * BM + wr * 64 + fr, col0 = u.pnl * HALF + wc * 32 + 8 * fq;
#pragma unroll
        for (int ai = 0; ai < 2; ++ai)
#pragma unroll
            for (int m = 0; m < 4; ++m) {
                float v[8];
#pragma unroll
                for (int n = 0; n < 2; ++n)
#pragma unroll
                    for (int j = 0; j < 4; ++j) { const float g = acc[ai][0][m][n][j], up = acc[ai][1][m][n][j];
                        v[4 * n + j] = g * __builtin_amdgcn_rcpf(1.0f + __builtin_amdgcn_exp2f(-1.4426950408889634f * g)) * up; }
                u32x4 w; w.x = cvt_pk_bf16(v[0], v[1]); w.y = cvt_pk_bf16(v[2], v[3]); w.z = cvt_pk_bf16(v[4], v[5]); w.w = cvt_pk_bf16(v[6], v[7]);
                *(u32x4*)(O + (size_t)(row0 + ai * HALF + m * 16) * ldc + col0) = w;
            }
    }
};
struct EpiSwiglu8 {
    static constexpr bool PERM = true, AFTER_DRAIN = false;
    unsigned char* O; int ldc; float gsc, usc;
    bool o16;
    const PG8_LAS unsigned char* rsb;
    __device__ __forceinline__ void operator()(const f32x4 (&acc)[2][2][4][2], const Unit& u, int wr, int wc, int fr, int fq) const {
        const int row0 = u.pm * BM + wr * 64 + fr, col0 = u.pnl * HALF + wc * 32 + 8 * fq;
        const float esc0 = -1.4426950408889634f * gsc, psc0 = gsc * usc;
        const PG8_LAS float* rst = nullptr;
        if (rsb) { const PG8_LAS int* pml = (const PG8_LAS int*)(rsb - 16); const int sl = pml[0] == u.pm ? 0 : (pml[1] == u.pm ? 1 : (pml[2] == u.pm ? 2 : 3));
            rst = (const PG8_LAS float*)rsb + sl * 256 + wr * 64 + fr; }
#pragma unroll
        for (int ai = 0; ai < 2; ++ai)
#pragma unroll
            for (int m = 0; m < 4; ++m) {
                float esc = esc0, psc = psc0;
                if (rsb) { const float r = rst[ai * HALF + m * 16]; esc *= r; psc *= r * r; }
                const float c0 = __builtin_amdgcn_rcpf(psc);
                float v[8];
#pragma unroll
                for (int n = 0; n < 2; ++n)
#pragma unroll
                    for (int j = 0; j < 4; ++j) { const float a = acc[ai][0][m][n][j], b = acc[ai][1][m][n][j];
                        const float r = __builtin_amdgcn_rcpf(__builtin_fmaf(__builtin_amdgcn_exp2f(a * esc), c0, c0));
                        const float t = (a * b) * r;
                        v[4 * n + j] = o16 ? t : __builtin_amdgcn_fmed3f(t, -448.0f, 448.0f); }
                if (o16) { u32x4 w; w.x = cvt_pk_bf16(v[0], v[1]); w.y = cvt_pk_bf16(v[2], v[3]); w.z = cvt_pk_bf16(v[4], v[5]); w.w = cvt_pk_bf16(v[6], v[7]);
                    *(PG8_GAS u32x4*)((PG8_GAS bf16_t*)O + (size_t)(row0 + ai * HALF + m * 16) * ldc + col0) = w; continue; }
                int w0 = 0, w1 = 0;
                w0 = __builtin_amdgcn_cvt_pk_fp8_f32(v[0], v[1], w0, false); w0 = __builtin_amdgcn_cvt_pk_fp8_f32(v[2], v[3], w0, true);
                w1 = __builtin_amdgcn_cvt_pk_fp8_f32(v[4], v[5], w1, false); w1 = __builtin_amdgcn_cvt_pk_fp8_f32(v[6], v[7], w1, true);
                typedef int i32x2 __attribute__((ext_vector_type(2)));
                *(PG8_GAS i32x2*)((PG8_GAS unsigned char*)O + (size_t)(row0 + ai * HALF + m * 16) * ldc + col0) = (i32x2){w0, w1};
            }
    }
};
struct EpiRes {
    static constexpr bool PERM = false, AFTER_DRAIN = false;
    const float* base; float* out; int ldc; float scale; bf16_t* out16;
    __device__ __forceinline__ void operator()(const f32x4 (&acc)[2][2][4][2], const Unit& u, int wr, int wc, int fr, int fq) const {
        const int row0 = u.pm * BM + wr * 64 + fr, col0 = u.pnl * BM + wc * 32 + 4 * fq;
        if (ldc < 0) {
            const bool second = ldc != -DM; const int ld = DM;
            unsigned char* wsb = (unsigned char*)out - (second ? WS_HB : WS_HA);
            const float* nwc = (const float*)(wsb + WS_SMALL + SM_NWC) + (second ? DM : 0); bf16_t* an = (bf16_t*)(wsb + WS_HN); float* ssp = (float*)(wsb + WS_SMALL + SM_SS);
            const PG8_GAS float* gbase = (const PG8_GAS float*)base; PG8_GAS float* gout = (PG8_GAS float*)out; PG8_GAS bf16_t* gan = (PG8_GAS bf16_t*)an;
            PG8_GAS unsigned char* gan8 = (PG8_GAS unsigned char*)(wsb + WS_HN8); PG8_GAS float* gssp = (PG8_GAS float*)ssp; const PG8_GAS float* gnwc = (const PG8_GAS float*)nwc;
            f32x4 gw[2][2];
#pragma unroll
            for (int bj = 0; bj < 2; ++bj)
#pragma unroll
                for (int n = 0; n < 2; ++n) gw[bj][n] = second ? (f32x4){0.f, 0.f, 0.f, 0.f} : *(const PG8_GAS f32x4*)(gnwc + col0 + bj * HALF + n * 16);
            typedef unsigned u32x2_ __attribute__((ext_vector_type(2)));
            PG8_GAS bf16_t* gout16 = (PG8_GAS bf16_t*)out; const PG8_GAS bf16_t* gbase16 = (const PG8_GAS bf16_t*)base;
            f32x4 bq[2][4]; u32x2_ bh[2][4];
#define PG8_ER_LD(G, D) do { const size_t off_ = (size_t)(row0 + ((G) >> 2) * HALF + ((G) & 3) * 16) * ld + col0; _Pragma("unroll") for (int q_ = 0; q_ < 4; ++q_) D[q_] = *(const PG8_GAS f32x4*)(gbase + off_ + (q_ >> 1) * HALF + (q_ & 1) * 16); } while (0)
#define PG8_ER_LDH(G, D) do { const size_t off_ = (size_t)(row0 + ((G) >> 2) * HALF + ((G) & 3) * 16) * ld + col0; _Pragma("unroll") for (int q_ = 0; q_ < 4; ++q_) D[q_] = *(const PG8_GAS u32x2_*)(gbase16 + off_ + (q_ >> 1) * HALF + (q_ & 1) * 16); } while (0)
#define PG8_BF4(X) ((f32x4){__builtin_bit_cast(float, (X).x << 16), __builtin_bit_cast(float, (X).x & 0xffff0000u), __builtin_bit_cast(float, (X).y << 16), __builtin_bit_cast(float, (X).y & 0xffff0000u)})
            if (second) PG8_ER_LDH(0, bh[0]); else PG8_ER_LD(0, bq[0]);
#pragma unroll
            for (int g = 0; g < 8; ++g) { const int ai = g >> 2, m = g & 3;
                if (g + 1 < 8) { if (second) PG8_ER_LDH(g + 1, bh[(g + 1) & 1]); else PG8_ER_LD(g + 1, bq[(g + 1) & 1]); }
                const int row = row0 + ai * HALF + m * 16; const size_t off = (size_t)row * ld + col0; float sq = 0.f;
#pragma unroll
                for (int bj = 0; bj < 2; ++bj)
#pragma unroll
                    for (int n = 0; n < 2; ++n) { const f32x4 bv = second ? PG8_BF4(bh[g & 1][bj * 2 + n]) : bq[g & 1][bj * 2 + n];
                        const f32x4 v = acc[ai][bj][m][n] * scale + bv;
                        *(PG8_GAS u32x2_*)(gout16 + off + bj * HALF + n * 16) = (u32x2_){cvt_pk_bf16(v[0], v[1]), cvt_pk_bf16(v[2], v[3])};
                        sq += (v[0] * v[0] + v[1] * v[1]) + (v[2] * v[2] + v[3] * v[3]);
                        if (!second) { const f32x4 a = v * gw[bj][n]; int w8 = 0;       w8 = __builtin_amdgcn_cvt_pk_fp8_f32(a[0], a[1], w8, false); w8 = __builtin_amdgcn_cvt_pk_fp8_f32(a[2], a[3], w8, true);
                            *(PG8_GAS int*)(gan8 + off + bj * HALF + n * 16) = w8; } }
                sq = xrow_sum4(sq);
                if (fq == 0) gssp[(size_t)row * 32 + u.pnl * 4 + wc] = sq; }
            return;
        }
        if (u.tl() >= 0) {
            PG8_GAS float* pt = (PG8_GAS float*)out + (size_t)(u.tl() * u.ks() + u.kp()) * (BM * BM) + (size_t)(wr * 64 + fr) * BM + wc * 32 + 4 * fq;
#pragma unroll
            for (int ai = 0; ai < 2; ++ai)
#pragma unroll
                for (int m = 0; m < 4; ++m)
#pragma unroll
                    for (int bj = 0; bj < 2; ++bj)
#pragma unroll
                        for (int n = 0; n < 2; ++n) *(PG8_GAS f32x4*)(pt + (size_t)(ai * HALF + m * 16) * BM + bj * HALF + n * 16) = acc[ai][bj][m][n] * scale;
            return;
        }
        if (base && !out16) {
            typedef unsigned u32x2_ __attribute__((ext_vector_type(2)));
            const PG8_GAS bf16_t* gbase16 = (const PG8_GAS bf16_t*)base; PG8_GAS bf16_t* gout16 = (PG8_GAS bf16_t*)out; const int ld = ldc;
            u32x2_ bh[2][4];
            PG8_ER_LDH(0, bh[0]);
#pragma unroll
            for (int g = 0; g < 8; ++g) { const int ai = g >> 2, m = g & 3;
                if (g + 1 < 8) PG8_ER_LDH(g + 1, bh[(g + 1) & 1]);
                const size_t off = (size_t)(row0 + ai * HALF + m * 16) * ldc + col0;
#pragma unroll
                for (int bj = 0; bj < 2; ++bj)
#pragma unroll
                    for (int n = 0; n < 2; ++n) { const f32x4 v = acc[ai][bj][m][n] * scale + PG8_BF4(bh[g & 1][bj * 2 + n]);
                        *(PG8_GAS u32x2_*)(gout16 + off + bj * HALF + n * 16) = (u32x2_){cvt_pk_bf16(v[0], v[1]), cvt_pk_bf16(v[2], v[3])}; } }
            return;
        }
#pragma unroll
        for (int ai = 0; ai < 2; ++ai)
#pragma unroll
            for (int m = 0; m < 4; ++m) { const size_t off = (size_t)(row0 + ai * HALF + m * 16) * ldc + col0;
#pragma unroll
                for (int bj = 0; bj < 2; ++bj)
#pragma unroll
                    for (int n = 0; n < 2; ++n) { f32x4 v = acc[ai][bj][m][n] * scale;
                        if (out16) { typedef unsigned u32x2_ __attribute__((ext_vector_type(2))); *(PG8_GAS u32x2_*)((PG8_GAS bf16_t*)out16 + off + bj * HALF + n * 16) = (u32x2_){cvt_pk_bf16(v[0], v[1]), cvt_pk_bf16(v[2], v[3])}; }
                        else { if (base) v += *(const f32x4*)(base + off + bj * HALF + n * 16); *(f32x4*)(out + off + bj * HALF + n * 16) = v; } } }
    }
};

template <class Epi, class Sched, bool ALIGN_EPI = false, bool SP2 = false, bool FP8 = false>
__device__ __forceinline__ void gemm_phase(PG8_LAS unsigned char* lds, const Gemm g, const Sched& S, const Epi& E) {
    int tid_ = threadIdx.x; asm volatile("" : "+v"(tid_));
    const int tid = tid_, wid = __builtin_amdgcn_readfirstlane(tid >> 6), lane = tid & 63, wr = wid >> 2, wc = wid & 3, fr = lane & 15, fq = lane >> 4;
    const int K = g.K, nt = K / BK;
    unsigned voffA[2], voffB[2];
#pragma unroll
    for (int i = 0; i < 2; ++i) { int R, C; stage_rc(tid * 16 + i * 8192, R, C); const int Rb = Epi::PERM ? ((R & ~31) + perm32(R & 31)) : R;
        voffA[i] = (unsigned)(R * K + C) * 2u; voffB[i] = (unsigned)(Rb * K + C) * 2u; }
    const size_t kstep = (size_t)(BK * 2);
    const size_t hstep = (size_t)HALF * K * 2;
    const size_t tstep = 2 * hstep;
    const unsigned ldsw = (unsigned)wid * 1024u;
    const int aoff = lds_byte(wr * 64 + fr, fq * 8), boff = lds_byte(wc * 32 + fr, fq * 8);
#define PG8_SA(b, h) (((b) * 2 + (h)) * HTB)
#define PG8_SB(b, h) ((4 + (b) * 2 + (h)) * HTB)
#define PG8_STAGE(bufoff, gbase, voff) do { _Pragma("unroll") for (int _i = 0; _i < 2; ++_i) \
        __builtin_amdgcn_global_load_lds((const unsigned*)((const char*)(gbase) + (voff)[_i]), (PG8_LAS unsigned*)(lds + (bufoff) + ldsw + _i * 8192), 16, 0, 0); } while (0)
#define PG8_LDA(dst, b, h) do { _Pragma("unroll") for (int m = 0; m < 4; ++m) { dst[m].lo = *(const PG8_LAS bf16x8*)(lds + PG8_SA(b, h) + aoff + m * 2048); dst[m].hi = *(const PG8_LAS bf16x8*)(lds + PG8_SA(b, h) + aoff + m * 2048 + 1024); } } while (0)
#define PG8_LDB(dst, b, h) do { _Pragma("unroll") for (int n = 0; n < 2; ++n) { dst[n].lo = *(const PG8_LAS bf16x8*)(lds + PG8_SB(b, h) + boff + n * 2048); dst[n].hi = *(const PG8_LAS bf16x8*)(lds + PG8_SB(b, h) + boff + n * 2048 + 1024); } } while (0)
#define PG8_MMA(ai, bj, At, Bt) do { __builtin_amdgcn_s_setprio(1); _Pragma("unroll") for (int m = 0; m < 4; ++m) _Pragma("unroll") for (int n = 0; n < 2; ++n) { \
        if constexpr (FP8) { typedef int v8i_ __attribute__((ext_vector_type(8))); \
            asm volatile("v_mfma_scale_f32_16x16x128_f8f6f4 %0, %1, %2, %0, %3, %3 op_sel_hi:[0,0,0]" : "+v"(acc[ai][bj][m][n]) : "v"(__builtin_bit_cast(v8i_, Bt[n])), "v"(__builtin_bit_cast(v8i_, At[m])), "v"(sc1_)); } \
        else { acc[ai][bj][m][n] = __builtin_amdgcn_mfma_f32_16x16x32_bf16(Bt[n].lo, At[m].lo, acc[ai][bj][m][n], 0, 0, 0); acc[ai][bj][m][n] = __builtin_amdgcn_mfma_f32_16x16x32_bf16(Bt[n].hi, At[m].hi, acc[ai][bj][m][n], 0, 0, 0); } } \
        __builtin_amdgcn_s_setprio(0); } while (0)
#define PG8_WAIT_V(n) asm volatile("s_waitcnt vmcnt(" #n ")" ::: "memory")
#define PG8_WAIT_L(n) asm volatile("s_waitcnt lgkmcnt(" #n ")" ::: "memory")
#define PG8_BAR __builtin_amdgcn_s_barrier()
#define PG8_SCHED __builtin_amdgcn_sched_barrier(0)
    Unit cur, nxt; int ui = 0;
    if (!S.next(0, cur)) return;
    f32x4 acc[2][2][4][2];
#pragma unroll
    for (int a = 0; a < 2; ++a)
#pragma unroll
        for (int b = 0; b < 2; ++b)
#pragma unroll
            for (int m = 0; m < 4; ++m)
#pragma unroll
                for (int n = 0; n < 2; ++n) acc[a][b][m][n] = (f32x4){0.f, 0.f, 0.f, 0.f};
    typedef short s16x16 __attribute__((ext_vector_type(16)));
    s16x16 At[4], B0[2], B1[2];
    int sc1_ = 0x7f7f7f7f; asm volatile("" : "+v"(sc1_));
    const char* cA = (const char*)g.A + (size_t)cur.pm * tstep + (size_t)(cur.kp() * (nt / cur.ks())) * kstep; const char* cB = (const char*)g.Bt + (size_t)cur.pn * tstep + (size_t)(cur.kp() * (nt / cur.ks())) * kstep;
    S.a_ready(cur);
    if constexpr (SP2) {
        PG8_STAGE(PG8_SB(0, 0), cB, voffB); PG8_STAGE(PG8_SB(0, 1), cB + hstep, voffB); PG8_STAGE(PG8_SA(0, 0), cA, voffA); PG8_STAGE(PG8_SA(0, 1), cA + hstep, voffA);
        if (wr == 1) PG8_BAR;
        PG8_WAIT_V(2); PG8_BAR;
        PG8_STAGE(PG8_SB(1, 0), cB + kstep, voffB); PG8_STAGE(PG8_SA(1, 0), cA + kstep, voffA); PG8_STAGE(PG8_SB(1, 1), cB + hstep + kstep, voffB);
        PG8_WAIT_V(6); PG8_BAR;
    } else {
        PG8_STAGE(PG8_SB(0, 0), cB, voffB); PG8_STAGE(PG8_SA(0, 0), cA, voffA); PG8_STAGE(PG8_SB(0, 1), cB + hstep, voffB); PG8_STAGE(PG8_SA(0, 1), cA + hstep, voffA);
        if (wr == 1) PG8_BAR;
        PG8_WAIT_V(4); PG8_BAR;
        PG8_STAGE(PG8_SB(1, 0), cB + kstep, voffB); PG8_STAGE(PG8_SA(1, 0), cA + kstep, voffA); PG8_STAGE(PG8_SB(1, 1), cB + hstep + kstep, voffB);
        PG8_WAIT_V(6); PG8_BAR;
    }
    for (;;) {
        const bool has_next = S.next(ui + 1, nxt);
        const char* nA = has_next ? (const char*)g.A + (size_t)nxt.pm * tstep + (size_t)(nxt.kp() * (nt / nxt.ks())) * kstep : cA; const char* nB = has_next ? (const char*)g.Bt + (size_t)nxt.pn * tstep + (size_t)(nxt.kp() * (nt / nxt.ks())) * kstep : cB;
        const int ntc = nt / cur.ks();
        for (int t = 0; t < ntc; t += 2) {
            const bool last = (t == ntc - 2);
            const char* a1 = cA + (size_t)(t + 1) * kstep;
            const char* a2 = last ? nA : cA + (size_t)(t + 2) * kstep; const char* b2 = last ? nB : cB + (size_t)(t + 2) * kstep;
            const char* a3 = a2 + kstep; const char* b3 = b2 + kstep;
            if (last && has_next) S.a_ready(nxt);
            if constexpr (SP2) {
            PG8_LDB(B0, 0, 0); PG8_LDB(B1, 0, 1); PG8_SCHED; PG8_LDA(At, 0, 0); PG8_STAGE(PG8_SA(1, 1), a1 + hstep, voffA);
            PG8_WAIT_V(8); PG8_WAIT_L(0); PG8_BAR; PG8_MMA(0, 0, At, B0); PG8_MMA(0, 1, At, B1); PG8_BAR; PG8_SCHED;
            PG8_LDA(At, 0, 1); PG8_STAGE(PG8_SB(0, 0), b2, voffB); PG8_STAGE(PG8_SB(0, 1), b2 + hstep, voffB); PG8_STAGE(PG8_SA(0, 0), a2, voffA);
            PG8_WAIT_V(8); PG8_WAIT_L(0); PG8_BAR; PG8_MMA(1, 0, At, B0); PG8_MMA(1, 1, At, B1); PG8_BAR; PG8_SCHED;
            PG8_LDB(B0, 1, 0); PG8_LDB(B1, 1, 1); PG8_SCHED; PG8_LDA(At, 1, 0); PG8_STAGE(PG8_SA(0, 1), a2 + hstep, voffA);
            PG8_WAIT_V(8); PG8_WAIT_L(0); PG8_BAR; PG8_MMA(0, 0, At, B0); PG8_MMA(0, 1, At, B1); PG8_BAR; PG8_SCHED;
            PG8_LDA(At, 1, 1); PG8_STAGE(PG8_SB(1, 0), b3, voffB); PG8_STAGE(PG8_SB(1, 1), b3 + hstep, voffB); PG8_STAGE(PG8_SA(1, 0), a3, voffA);
            PG8_WAIT_V(8); PG8_WAIT_L(0); PG8_BAR; PG8_MMA(1, 0, At, B0); PG8_MMA(1, 1, At, B1); PG8_BAR; PG8_SCHED;
            } else {
            PG8_LDB(B0, 0, 0); PG8_SCHED; PG8_LDA(At, 0, 0); PG8_STAGE(PG8_SA(1, 1), a1 + hstep, voffA);
            PG8_WAIT_L(8); PG8_BAR; PG8_WAIT_L(0); PG8_MMA(0, 0, At, B0); PG8_BAR; PG8_SCHED;
            PG8_LDB(B1, 0, 1); PG8_STAGE(PG8_SB(0, 0), b2, voffB);
            PG8_BAR; PG8_WAIT_L(0); PG8_MMA(0, 1, At, B1); PG8_BAR;
            PG8_LDA(At, 0, 1); PG8_STAGE(PG8_SA(0, 0), a2, voffA);
            PG8_BAR; PG8_WAIT_L(0); PG8_MMA(1, 0, At, B0); PG8_BAR; PG8_SCHED;
            PG8_STAGE(PG8_SB(0, 1), b2 + hstep, voffB);
            PG8_WAIT_V(6); PG8_BAR; PG8_MMA(1, 1, At, B1); PG8_BAR;
            PG8_LDB(B0, 1, 0); PG8_SCHED; PG8_LDA(At, 1, 0); PG8_STAGE(PG8_SA(0, 1), a2 + hstep, voffA);
            PG8_WAIT_L(8); PG8_BAR; PG8_WAIT_L(0); PG8_MMA(0, 0, At, B0); PG8_BAR; PG8_SCHED;
            PG8_LDB(B1, 1, 1); PG8_STAGE(PG8_SB(1, 0), b3, voffB);
            PG8_BAR; PG8_WAIT_L(0); PG8_MMA(0, 1, At, B1); PG8_BAR;
            PG8_LDA(At, 1, 1); PG8_STAGE(PG8_SA(1, 0), a3, voffA);
            PG8_BAR; PG8_WAIT_L(0); PG8_MMA(1, 0, At, B0); PG8_BAR; PG8_SCHED;
            PG8_STAGE(PG8_SB(1, 1), b3 + hstep, voffB);
            PG8_WAIT_V(6); PG8_BAR; PG8_MMA(1, 1, At, B1); PG8_BAR;
            }
        }
        if constexpr (ALIGN_EPI) { if (wr == 0) PG8_BAR; }
        if constexpr (FP8) asm volatile("s_nop 15\n\ts_nop 15" ::: "memory");
        if constexpr (!Epi::AFTER_DRAIN) { E(acc, cur, wr, wc, fr, fq); S.done(cur); }
        if (!has_next) break;
#pragma unroll
        for (int a = 0; a < 2; ++a)
#pragma unroll
            for (int b = 0; b < 2; ++b)
#pragma unroll
                for (int m = 0; m < 4; ++m)
#pragma unroll
                    for (int n = 0; n < 2; ++n) acc[a][b][m][n] = (f32x4){0.f, 0.f, 0.f, 0.f};
        cur = nxt; cA = nA; cB = nB; ++ui;
        if constexpr (ALIGN_EPI) { if (wr == 1) PG8_BAR; }
    }
    PG8_WAIT_V(0);
    if constexpr (!ALIGN_EPI) { if (wr == 0) PG8_BAR; }
    PG8_BAR;
#undef PG8_SA
#undef PG8_SB
#undef PG8_STAGE
#undef PG8_LDA
#undef PG8_LDB
#undef PG8_MMA
#undef PG8_WAIT_V
#undef PG8_WAIT_L
#undef PG8_BAR
#undef PG8_SCHED
}
}


#define GAS __attribute__((address_space(1)))
#define LAS __attribute__((address_space(3)))
typedef unsigned short bf16;
typedef unsigned v4u __attribute__((ext_vector_type(4)));
typedef unsigned v2u __attribute__((ext_vector_type(2)));
typedef float f32x4 __attribute__((ext_vector_type(4)));
typedef float f32x2 __attribute__((ext_vector_type(2)));
typedef short bf16x8 __attribute__((ext_vector_type(8)));
typedef short s16x4 __attribute__((ext_vector_type(4)));
#define LDS_WAIT() asm volatile("s_waitcnt lgkmcnt(0)" ::: "memory")
__device__ __forceinline__ unsigned f2bf(float f) { unsigned u = __builtin_bit_cast(unsigned, f); return (u + 0x7fffu + ((u >> 16) & 1u)) >> 16; }
__device__ __forceinline__ unsigned pk2(float lo, float hi) { return f2bf(lo) | (f2bf(hi) << 16); }
__device__ __forceinline__ float bf2f(unsigned b) { return __builtin_bit_cast(float, b << 16); }
__device__ __forceinline__ float bflo(unsigned w) { return __builtin_bit_cast(float, w << 16); }
__device__ __forceinline__ float bfhi(unsigned w) { return __builtin_bit_cast(float, w & 0xffff0000u); }
__device__ __forceinline__ float wave_sum(float v) {
    int x = __builtin_bit_cast(int, v);
#define WS_DPP_ADD(ctrl, rmask) x = __builtin_bit_cast(int, __builtin_bit_cast(float, x) + __builtin_bit_cast(float, __builtin_amdgcn_update_dpp(0, x, (ctrl), (rmask), 0xF, false)))
    WS_DPP_ADD(0x121, 0xF); WS_DPP_ADD(0x122, 0xF); WS_DPP_ADD(0x124, 0xF); WS_DPP_ADD(0x128, 0xF);
    WS_DPP_ADD(0x142, 0xA);
    WS_DPP_ADD(0x143, 0xC);
#undef WS_DPP_ADD
    return __builtin_bit_cast(float, __builtin_amdgcn_readlane(x, 63));
}
__device__ __forceinline__ int wave_sum_i(int v) {
#pragma unroll
    for (int o = 1; o < 64; o <<= 1) v += __shfl_xor(v, o);
    return v;
}
__device__ __forceinline__ float xrow_sum(float v) {
    { const unsigned x = __builtin_bit_cast(unsigned, v); const auto r = __builtin_amdgcn_permlane32_swap(x, x, false, false); v = __builtin_bit_cast(float, (unsigned)r[0]) + __builtin_bit_cast(float, (unsigned)r[1]); }
    { const unsigned x = __builtin_bit_cast(unsigned, v); const auto r = __builtin_amdgcn_permlane16_swap(x, x, false, false); v = __builtin_bit_cast(float, (unsigned)r[0]) + __builtin_bit_cast(float, (unsigned)r[1]); }
    return v;
}
__device__ __forceinline__ float xrow_max(float v) {
    { const unsigned x = __builtin_bit_cast(unsigned, v); const auto r = __builtin_amdgcn_permlane32_swap(x, x, false, false); v = fmaxf(__builtin_bit_cast(float, (unsigned)r[0]), __builtin_bit_cast(float, (unsigned)r[1])); }
    { const unsigned x = __builtin_bit_cast(unsigned, v); const auto r = __builtin_amdgcn_permlane16_swap(x, x, false, false); v = fmaxf(__builtin_bit_cast(float, (unsigned)r[0]), __builtin_bit_cast(float, (unsigned)r[1])); }
    return v;
}
__device__ __forceinline__ float row16_sum(float v) {
    int x = __builtin_bit_cast(int, v);
#define R16_ADD(ctrl) x = __builtin_bit_cast(int, __builtin_bit_cast(float, x) + __builtin_bit_cast(float, __builtin_amdgcn_update_dpp(0, x, (ctrl), 0xF, 0xF, false)))
    R16_ADD(0x121); R16_ADD(0x122); R16_ADD(0x124); R16_ADD(0x128);
#undef R16_ADD
    return __builtin_bit_cast(float, x);
}
__device__ __forceinline__ float sigmoidf_(float x) { return __builtin_amdgcn_rcpf(1.0f + __builtin_amdgcn_exp2f(-1.4426950408889634f * x)); }
__device__ __forceinline__ float siluf_(float x) { return x * sigmoidf_(x); }
__device__ __forceinline__ float fexp(float x) { return __builtin_amdgcn_exp2f(1.4426950408889634f * x); }

#define XB_TMO      128
#define XB_XCNT(j)  (256  + 64 * (j))
#define XB_XSUB(j)  (1280 + 64 * (j))
#define XB_XGEN(j)  (2304 + 64 * (j))
#define XB_TOP      3328
#define XB_TOPGEN   3392
#define XCD_BAR_WORDS 3456
#define XB_SPIN_CAP (1u << 18)
__device__ __forceinline__ unsigned xb_ld(unsigned* p)              { return __hip_atomic_load(p, __ATOMIC_RELAXED, __HIP_MEMORY_SCOPE_AGENT); }
__device__ __forceinline__ unsigned xb_add(unsigned* p, unsigned v) { return __hip_atomic_fetch_add(p, v, __ATOMIC_RELAXED, __HIP_MEMORY_SCOPE_AGENT); }
__device__ __forceinline__ unsigned xb_xcc_id() { return (unsigned)__builtin_amdgcn_s_getreg((3 << 11) | 20) & 0xFu; }
#define XB_SPIN(cond, bar) do { unsigned _sp = 0; while (cond) { __builtin_amdgcn_s_sleep(1); \
    if ((++_sp & 255u) == 0u) { if (xb_ld(&(bar)[XB_TMO])) break; if (_sp > XB_SPIN_CAP) { atomicAdd(&(bar)[XB_TMO], 1u); break; } } } } while (0)
struct XcdBarrier { unsigned* bar; unsigned x; volatile LAS unsigned* st; };
__device__ __forceinline__ XcdBarrier xcd_barrier_post(unsigned* bar, volatile LAS unsigned* st) {
    XcdBarrier b; b.bar = bar; b.x = xb_xcc_id(); b.st = st;
    if (threadIdx.x == 0) (void)xb_add(&bar[XB_XCNT(b.x)], 1u);
    return b;
}
__device__ __forceinline__ void xcd_barrier_complete(unsigned* bar, unsigned x, unsigned& nloc, unsigned& nx) {
    const unsigned G = gridDim.x * gridDim.y * gridDim.z;
    unsigned sum, cnt, mine, sp = 0u;
    for (;;) {
        sum = 0u; cnt = 0u; mine = 0u;
#pragma unroll
        for (unsigned j = 0; j < 16; ++j) { const unsigned c = xb_ld(&bar[XB_XCNT(j)]); sum += c; cnt += (c > 0u) ? 1u : 0u; mine = (j == x) ? c : mine; }
        if (sum == G) break;
        __builtin_amdgcn_s_sleep(1);
        if ((++sp & 255u) == 0u) { if (xb_ld(&bar[XB_TMO])) break; if (sp > XB_SPIN_CAP) { atomicAdd(&bar[XB_TMO], 1u); break; } }
    }
    nloc = mine > 0u ? mine : 1u; nx = cnt > 0u ? cnt : 1u;
}
__device__ __forceinline__ void xcd_barrier(const XcdBarrier& b) {
    asm volatile("s_waitcnt vmcnt(0)" ::: "memory");
    __syncthreads();
    if (threadIdx.x == 0) {
        unsigned* bar = b.bar;
        __builtin_amdgcn_s_waitcnt(0);
        unsigned nloc = b.st[0], nx = b.st[1];
        if (nloc == 0u) { xcd_barrier_complete(bar, b.x, nloc, nx); b.st[0] = nloc; b.st[1] = nx; }
        const unsigned old = xb_add(&bar[XB_XSUB(b.x)], 1u);
        const unsigned gen = old / nloc;
        if (old + 1u == (gen + 1u) * nloc) {
            __builtin_amdgcn_fence(__ATOMIC_RELEASE, "agent");
            asm volatile("s_waitcnt vmcnt(0)" ::: "memory");
            const unsigned og = xb_add(&bar[XB_TOP], 1u);
            const unsigned tg = og / nx;
            if (og + 1u == (tg + 1u) * nx) xb_add(&bar[XB_TOPGEN], 1u);
            else XB_SPIN(xb_ld(&bar[XB_TOPGEN]) == tg, bar);
            __builtin_amdgcn_fence(__ATOMIC_ACQUIRE, "agent");
            xb_add(&bar[XB_XGEN(b.x)], 1u);
            asm volatile("s_waitcnt vmcnt(0)" ::: "memory");
        } else {
            XB_SPIN(xb_ld(&bar[XB_XGEN(b.x)]) == gen, bar);
            __builtin_amdgcn_fence(__ATOMIC_ACQUIRE, "agent");
            asm volatile("s_waitcnt vmcnt(0)" ::: "memory");
        }
    }
    __syncthreads();
}

static __device__ __noinline__ void grid_barrier(LAS unsigned char* lds) {
    volatile LAS unsigned* MISC = (volatile LAS unsigned*)(lds + 131072);
    volatile LAS unsigned* ap = (volatile LAS unsigned*)(lds + 131072 + 1024) + 2 * 24; unsigned lo = ap[0], hi = ap[1];
    lo = __builtin_amdgcn_readfirstlane(lo); hi = __builtin_amdgcn_readfirstlane(hi);
    XcdBarrier b; b.bar = (unsigned*)(((unsigned long long)hi << 32) | lo) + 4096; b.x = __builtin_amdgcn_readfirstlane(MISC[2]); b.st = MISC;
    xcd_barrier(b);
}
template <int K>
__device__ __forceinline__ f32x4 mma_lds(f32x4 acc, const LAS unsigned char* A, int pa, const LAS unsigned char* Bt, int pb, int lane) {
    const int i = lane & 15, g = lane >> 4;
#pragma unroll
    for (int k = 0; k < K; k += 32) {
        const bf16x8 a = *(const LAS bf16x8*)(A + i * pa + (k + 8 * g) * 2);
        const bf16x8 b = *(const LAS bf16x8*)(Bt + i * pb + (k + 8 * g) * 2);
        acc = __builtin_amdgcn_mfma_f32_16x16x32_bf16(a, b, acc, 0, 0, 0);
    }
    return acc;
}

struct Args { const float* in[23]; float* out; unsigned char* ws; int ph_lo, ph_hi; };
enum { I_X = 0, I_NMIX, I_WIN, I_SCW, I_SCB, I_SDTB, I_SALOG, I_SD, I_SNW, I_CCW, I_CCB, I_CLW, I_CLB, I_WOUT, I_NFFN, I_FG, I_FU, I_FD, I_RT, I_MG, I_MU, I_MD, I_NFIN };

constexpr int ARGS_OFF = 131072 + 1024;
__device__ __forceinline__ const void* ldarg(LAS unsigned char* lds, int k) {
    volatile LAS unsigned* p = (volatile LAS unsigned*)(lds + ARGS_OFF) + 2 * k; unsigned lo = p[0], hi = p[1];
    lo = __builtin_amdgcn_readfirstlane(lo); hi = __builtin_amdgcn_readfirstlane(hi); return (const void*)(((unsigned long long)hi << 32) | lo); }
__device__ __forceinline__ const void* ldarg_g(LAS unsigned char* lds, int k) {
    volatile LAS unsigned* p = (volatile LAS unsigned*)(lds + ARGS_OFF) + 2 * k; unsigned lo = p[0], hi = p[1];
    lo = __builtin_amdgcn_readfirstlane(lo); hi = __builtin_amdgcn_readfirstlane(hi);
    const GAS char* gp = (const GAS char*)(((unsigned long long)hi << 32) | lo); return (const void*)gp; }
#define ARGWS_G() ((unsigned char*)ldarg_g(lds, 24))
#define ARGF_G(k) ((const float*)ldarg_g(lds, (k)))
#define ARGF(k) ((const float*)ldarg(lds, (k)))
#define ARGWS() ((unsigned char*)ldarg(lds, 24))
#define ARGOUT() ((float*)ldarg(lds, 23))
struct CvDesc { const float* src; unsigned char* dst; unsigned ld, pitchB; int f8; const float* gk; };
__device__ __forceinline__ void cv_load(const CvDesc& d, f32x4 (&v)[16], int lane) {
    const int kr = lane >> 4, c4 = lane & 15;
#pragma unroll
    for (int i = 0; i < 16; ++i) v[i] = __builtin_nontemporal_load((const f32x4*)(d.src + (size_t)(4 * i + kr) * d.ld + 4 * c4));
}
__device__ __forceinline__ void cv_store(const CvDesc& d, const f32x4 (&v)[16], LAS unsigned char* scr, int lane) {
    const int kr = lane >> 4, c4 = lane & 15;
    const float wsc = d.f8 ? 128.0f : 1.0f;
    if (d.gk) {
        float gr[16];
#pragma unroll
        for (int i = 0; i < 16; ++i) gr[i] = d.gk[4 * i + kr];
#pragma unroll
        for (int i = 0; i < 16; ++i) { const float ws2 = wsc * gr[i]; v2u w; w.x = pg8::cvt_pk_bf16(v[i][0] * ws2, v[i][1] * ws2); w.y = pg8::cvt_pk_bf16(v[i][2] * ws2, v[i][3] * ws2); *(LAS v2u*)(scr + (4 * i + kr) * 136 + 8 * c4) = w; }
    } else {
#pragma unroll
    for (int i = 0; i < 16; ++i) { v2u w; w.x = pg8::cvt_pk_bf16(v[i][0] * wsc, v[i][1] * wsc); w.y = pg8::cvt_pk_bf16(v[i][2] * wsc, v[i][3] * wsc); *(LAS v2u*)(scr + (4 * i + kr) * 136 + 8 * c4) = w; }
    }
    LDS_WAIT(); asm volatile("" ::: "memory");
    const int g = lane >> 4, i16 = lane & 15, q = i16 >> 2, p = i16 & 3;
    if (d.f8) {
#pragma unroll
        for (int j = 0; j < 4; ++j) {
            const int nb = 16 * j;
            int w[4];
#pragma unroll
            for (int r = 0; r < 4; ++r) {
                const s16x4 a = __builtin_amdgcn_ds_read_tr16_b64_v4i16((LAS s16x4*)(scr + (16 * g + 4 * r + q) * 136 + (nb + 4 * p) * 2));
                int t = 0; t = __builtin_amdgcn_cvt_pk_fp8_f32(bf2f((unsigned short)a[0]), bf2f((unsigned short)a[1]), t, false); t = __builtin_amdgcn_cvt_pk_fp8_f32(bf2f((unsigned short)a[2]), bf2f((unsigned short)a[3]), t, true);
                w[r] = t;
            }
            typedef int i32x4 __attribute__((ext_vector_type(4)));
            __builtin_nontemporal_store((i32x4){w[0], w[1], w[2], w[3]}, (i32x4*)(d.dst + (size_t)(nb + i16) * d.pitchB + 16 * g));
        }
        LDS_WAIT(); asm volatile("" ::: "memory");
        return;
    }
#pragma unroll
    for (int j = 0; j < 8; ++j) {
        const int nb = 16 * (j & 3), kc = (j >> 2) * 4 + g;
        const LAS unsigned char* ad = scr + (8 * kc + q) * 136 + (nb + 4 * p) * 2;
        const s16x4 a0 = __builtin_amdgcn_ds_read_tr16_b64_v4i16((LAS s16x4*)ad);
        const s16x4 a1 = __builtin_amdgcn_ds_read_tr16_b64_v4i16((LAS s16x4*)(ad + 4 * 136));
        unsigned char* rowp = d.dst + (size_t)(nb + i16) * d.pitchB;
        { const bf16x8 o = {a0[0], a0[1], a0[2], a0[3], a1[0], a1[1], a1[2], a1[3]};
            *(bf16x8*)(rowp + 16 * kc) = o; }
    }
    LDS_WAIT(); asm volatile("" ::: "memory");
}
constexpr int IT_IN = 32 * (NP / 64), IT_OUT = 32 * 32, IT_GU = 32 * 224, IT_DN = 112 * 32, IT_FF = IT_GU + IT_DN;
constexpr int IT_EARLY = 2 * IT_IN + 2 * IT_OUT + IT_FF;
constexpr int IT_TOTAL = IT_EARLY + 8 * IT_FF;
__device__ __forceinline__ CvDesc cv_decode(LAS unsigned char* lds, int it) {
    unsigned char* ws = ARGWS_G(); CvDesc d; d.gk = nullptr; int r = it;
    if (r < 2 * IT_IN) {
        const int l = r / IT_IN; r -= l * IT_IN; const int kb = r / (NP / 64), gi = r % (NP / 64), phys = 64 * gi; int scol;
        if (phys < 2048) { const int part = phys >> 10, within = phys & 1023, pn = within >> 8, bj = (within >> 7) & 1, o = within & 127; scol = part * 1024 + (2 * pn + (o >> 6)) * 128 + 64 * bj + (o & 63); }
        else if (phys < 4608) scol = phys; else scol = phys + 8;
        d.src = ARGF_G(I_WIN) + (size_t)l * DM * IN_DIM + (size_t)(64 * kb) * IN_DIM + scol; d.ld = IN_DIM; d.pitchB = DM * 2; d.f8 = 0;
        d.dst = ws + WS_WIN + ((size_t)l * NP * DM + (size_t)phys * DM + 64 * kb) * 2;
        if (l == 1) d.gk = ARGF_G(I_NMIX) + DM + 64 * kb;
        return d;
    }
    r -= 2 * IT_IN;
    if (r < 2 * IT_OUT) {
        const int l = r / IT_OUT; r -= l * IT_OUT; const int kb = r / 32, gi = r % 32;
        d.src = ARGF_G(I_WOUT) + (size_t)l * DM * DM + (size_t)(64 * kb) * DM + 64 * gi; d.ld = DM; d.pitchB = DM * 2; d.f8 = 0;
        d.dst = ws + WS_WOUT + ((size_t)l * DM * DM + (size_t)(64 * gi) * DM + 64 * kb) * 2; return d;
    }
    r -= 2 * IT_OUT;
    const int e9 = r / IT_FF; r -= e9 * IT_FF;
    if (r < IT_GU) {
        int kb = r / 224, gi = r % 224; if (e9) { kb = 2 * (r / 448) + (r & 1); gi = (r % 448) >> 1; }
        const int phys = 64 * gi, pn = phys >> 8, bj = (phys >> 7) & 1, o = phys & 127, ff = 128 * pn + o;
        const float* src = e9 == 0 ? ARGF_G(bj ? I_FU : I_FG) : (ARGF_G(bj ? I_MU : I_MG) + (size_t)(e9 - 1) * DM * DFF);
        d.src = src + (size_t)(64 * kb) * DFF + ff; d.ld = DFF;
        if (e9 == 0) { d.f8 = 1; d.pitchB = DM; d.dst = ws + WS_WGU + (size_t)phys * DM + 64 * kb; }
        else { d.f8 = 1; d.pitchB = DM; d.dst = ws + WS_WGU8 + (size_t)(e9 - 1) * 2 * DFF * DM + (size_t)phys * DM + 64 * kb; }
    } else {
        r -= IT_GU; int kb = r / 32, gi = r % 32; if (e9) { kb = 2 * (r / 64) + (r & 1); gi = (r % 64) >> 1; }
        const float* src = e9 == 0 ? ARGF_G(I_FD) : (ARGF_G(I_MD) + (size_t)(e9 - 1) * DFF * DM);
        d.src = src + (size_t)(64 * kb) * DM + 64 * gi; d.ld = DM;
        if (e9 == 0) { d.f8 = 0; d.pitchB = DFF * 2; d.dst = ws + WS_WDN + ((size_t)(64 * gi) * DFF + 64 * kb) * 2; }
        else { d.f8 = 1; d.pitchB = DFF; d.dst = ws + WS_WDN8 + (size_t)(e9 - 1) * DM * DFF + (size_t)(64 * gi) * DFF + 64 * kb; }
    }
    return d;
}
__device__ __forceinline__ void cv_run(LAS unsigned char* lds, LAS unsigned char* scr, int lane, int it0, int stride, int it_end) {
    asm volatile("" : "+v"(lane));
#pragma unroll 1
    for (int it = it0; it < it_end; it += stride) {
        const CvDesc da = cv_decode(lds, it); f32x4 va[16];
        cv_load(da, va, lane);
        cv_store(da, va, scr, lane);
    }
}
__device__ __forceinline__ void p0_prologue(LAS unsigned char* lds, int tid, int lane, int wave, int vcu, int G) {
    LAS unsigned char* scr = lds + wave * 16384;
    const int gw = vcu * NWAVES + wave, NGW = G * NWAVES;
    unsigned char* ws = ARGWS();
    cv_run(lds, scr, lane, gw, NGW, IT_IN);
    if (vcu == 0) { const float* nf = ARGF(I_NFFN); const float* nm = ARGF(I_NMIX) + DM; float* nwc = (float*)(ws + WS_SMALL + SM_NWC);
        for (int k = tid; k < DM; k += 512) { nwc[k] = nf[k]; nwc[DM + k] = nm[k]; } if (tid < 8) nwc[2 * DM + tid] = ARGF(I_SDTB)[8 + tid]; }
    if (vcu == 1 % G) {
        bf16* dtt = (bf16*)(ws + WS_WIN) + (size_t)2 * NP * DM; const float* wi = ARGF(I_WIN) + (size_t)DM * IN_DIM + 4608;
        for (int k = tid; k < DM; k += 512) { const float gk_ = ARGF(I_NMIX)[DM + k];
            const f32x4 a = *(const f32x4*)(wi + (size_t)k * IN_DIM) * gk_, b = *(const f32x4*)(wi + (size_t)k * IN_DIM + 4) * gk_;
            dtt[0 * DM + k] = (bf16)f2bf(a[0]); dtt[1 * DM + k] = (bf16)f2bf(a[1]); dtt[2 * DM + k] = (bf16)f2bf(a[2]); dtt[3 * DM + k] = (bf16)f2bf(a[3]);
            dtt[4 * DM + k] = (bf16)f2bf(b[0]); dtt[5 * DM + k] = (bf16)f2bf(b[1]); dtt[6 * DM + k] = (bf16)f2bf(b[2]); dtt[7 * DM + k] = (bf16)f2bf(b[3]); }
        v4u* z = (v4u*)(dtt + 8 * DM); const v4u zero = {0u, 0u, 0u, 0u};
        for (int q = tid; q < 248 * DM * 2 / 16; q += 512) z[q] = zero;
    }
    float* rope = (float*)(ws + WS_ROPE);
    for (int idx = (vcu * NWAVES + wave) * 64 + lane; idx < SEQ * 64; idx += NGW * 64) {
        const int pos = idx >> 6, i = idx & 63;
        const float inv = __builtin_amdgcn_exp2f(-(float)(2 * i) * (13.287712379549449f / 128.0f));
        const float ang = (float)pos * inv;
        const float t = ang * 0.15915494309189535f, fr = t - floorf(t);
        rope[2 * idx] = __builtin_amdgcn_cosf(fr); rope[2 * idx + 1] = __builtin_amdgcn_sinf(fr);
    }
}

template <int MODE>
static __device__ __noinline__ void norm_phase(LAS unsigned char* lds, int tid, int lane, int wave, int vcu, int G,
        const float* __restrict__ hin, const float* __restrict__ nw, bf16* __restrict__ hn, const float* __restrict__ wsm, size_t ldsm,
        const float* __restrict__ bias8, float* __restrict__ dt_out, int* __restrict__ tok_e, f32x2* __restrict__ tok_g, int* __restrict__ wcnt, int* __restrict__ bcnt) {
    const GAS float* hin_g = (const GAS float*)hin; const GAS float* nw_g = (const GAS float*)nw; GAS unsigned char* hn_g = (GAS unsigned char*)hn;
    GAS float* dt_g = (GAS float*)dt_out; GAS int* toke_g = (GAS int*)tok_e; GAS f32x2* tokg_g = (GAS f32x2*)tok_g;
    LAS f32x4* wlA = (LAS f32x4*)lds;
    LAS f32x4* wlB = (LAS f32x4*)(lds + 32768);
    LAS int* lcnt = (LAS int*)(lds + 65536);
    if (MODE != 2) for (int k = tid; k < DM; k += 512) { const f32x4 va = *(const f32x4*)(wsm + (size_t)k * ldsm), vb = *(const f32x4*)(wsm + (size_t)k * ldsm + 4);
        const int j = k >> 8, ln = (k & 255) >> 2, e = k & 3, slot = (j * 4 + e) * 64 + ln; wlA[slot] = va; wlB[slot] = vb; }
    if (MODE == 1 && tid < 8) lcnt[tid] = 0;
    LAS f32x4* wlG = (LAS f32x4*)(lds + 65536 + 256);
    wlG[tid] = *(const GAS f32x4*)(nw_g + 4 * tid);
    __syncthreads();
    const int NGW = G * NWAVES, gw = vcu * NWAVES + wave, RPW = (M + NGW - 1) / NGW;
    int mycnt = 0;
    f32x4 xn[8]; v2u xh[8];
    const GAS bf16* hin16 = (const GAS bf16*)hin_g;
    { const int r0 = min(gw * RPW, M - 1);
#pragma unroll
      for (int j = 0; j < 8; ++j) { if (MODE == 1) xh[j] = *(const GAS v2u*)(hin16 + (size_t)r0 * DM + 4 * lane + 256 * j); else xn[j] = *(const GAS f32x4*)(hin_g + (size_t)r0 * DM + 4 * lane + 256 * j); } }
    for (int i = 0; i < RPW; ++i) {
        const int row = gw * RPW + i; if (row >= M) break;
        f32x4 x[8]; float ss = 0.f;
#pragma unroll
        for (int j = 0; j < 8; ++j) { x[j] = MODE == 1 ? (f32x4){bflo(xh[j].x), bfhi(xh[j].x), bflo(xh[j].y), bfhi(xh[j].y)} : xn[j]; ss += (x[j][0] * x[j][0] + x[j][1] * x[j][1]) + (x[j][2] * x[j][2] + x[j][3] * x[j][3]); }
        { const int rn = min(row + 1, M - 1);
#pragma unroll
          for (int j = 0; j < 8; ++j) { if (MODE == 1) xh[j] = *(const GAS v2u*)(hin16 + (size_t)rn * DM + 4 * lane + 256 * j); else xn[j] = *(const GAS f32x4*)(hin_g + (size_t)rn * DM + 4 * lane + 256 * j); } }
        ss = wave_sum(ss);
        const float rstd = 1.0f / sqrtf(ss * (1.0f / DM) + EPS);
        f32x4 accA = {0.f, 0.f, 0.f, 0.f}, accB = {0.f, 0.f, 0.f, 0.f};
#pragma unroll
        for (int j = 0; j < 8; ++j) {
            const f32x4 y = x[j] * rstd * wlG[j * 64 + lane];
            if (MODE == 1) { int w8 = 0; w8 = __builtin_amdgcn_cvt_pk_fp8_f32(y[0], y[1], w8, false); w8 = __builtin_amdgcn_cvt_pk_fp8_f32(y[2], y[3], w8, true);
                *(GAS int*)(hn_g + (size_t)row * DM + 4 * lane + 256 * j) = w8; }
            else { v2u o; o.x = pk2(y[0], y[1]); o.y = pk2(y[2], y[3]);
            *(GAS v2u*)(hn_g + ((size_t)row * DM + 4 * lane + 256 * j) * 2) = o; }
            if (MODE != 2) {
#pragma unroll
            for (int e = 0; e < 4; ++e) { const f32x4 wa = wlA[(j * 4 + e) * 64 + lane], wb = wlB[(j * 4 + e) * 64 + lane]; accA += y[e] * wa; accB += y[e] * wb; }
            }
        }
        if (MODE == 2) continue;
        float acc[8];
#pragma unroll
        for (int c = 0; c < 4; ++c) { acc[c] = wave_sum(accA[c]); acc[4 + c] = wave_sum(accB[c]); }
        if (MODE == 0) {
            float v = acc[0];
#pragma unroll
            for (int c = 1; c < 8; ++c) v = (lane == c) ? acc[c] : v;
            if (lane < 8) { const float xx = v + bias8[lane]; dt_g[(size_t)row * 8 + lane] = fmaxf(xx, 0.f) + log1pf(expf(-fabsf(xx))); }
        } else {
            float v0 = acc[0]; int i0 = 0;
#pragma unroll
            for (int c = 1; c < 8; ++c) if (acc[c] > v0) { v0 = acc[c]; i0 = c; }
            float v1 = -INFINITY; int i1 = 0;
#pragma unroll
            for (int c = 0; c < 8; ++c) if (c != i0 && acc[c] > v1) { v1 = acc[c]; i1 = c; }
            const float ex = expf(v1 - v0), g0 = 1.0f / (1.0f + ex), g1 = ex * g0;
            if (lane == 0) { toke_g[row] = i0 | (i1 << 8); tokg_g[row] = (f32x2){g0, g1}; }
            if (lane == i0 || lane == i1) ++mycnt;
        }
    }
    if (MODE == 1) {
        if (lane < 8) { wcnt[gw * 8 + lane] = mycnt; __hip_atomic_fetch_add(lcnt + lane, mycnt, __ATOMIC_RELAXED, __HIP_MEMORY_SCOPE_WORKGROUP); }
        __syncthreads();
        if (tid < 8) bcnt[vcu * 8 + tid] = lcnt[tid];
    }
    __syncthreads();
}

static __device__ __noinline__ void gather_phase(LAS unsigned char* lds, int tid, int lane, int wave, int vcu, int G) {
    unsigned char* ws = ARGWS_G();
    LAS int* tt = (LAS int*)lds;
    const int* bcnt = (const int*)(ws + WS_SMALL + SM_BCNT); const int* wcnt = (const int*)(ws + WS_SMALL + SM_WCNT);
    const int* tok_e = (const int*)(ws + WS_SMALL + SM_TOKE); int* pos = (int*)(ws + WS_SMALL + SM_POS);
    const unsigned char* hn = ws + WS_HN8; unsigned char* xp = ws + WS_XP8;
    { int st = 0, sp = 0; for (int b2 = lane; b2 < G; b2 += 64) { const int v = bcnt[b2 * 8 + wave]; st += v; if (b2 < vcu) sp += v; }
      st = wave_sum_i(st); sp = wave_sum_i(sp); if (lane == 0) { tt[wave] = st; tt[8 + wave] = sp; } }
    __syncthreads();
    int run = 0;
    if (lane < 8) { int base = 0;
#pragma unroll
        for (int e2 = 0; e2 < 8; ++e2) if (e2 < lane) base += ((tt[e2] + 255) >> 8) << 8;
        run = base + tt[8 + lane];
        for (int w2 = 0; w2 < wave; ++w2) run += wcnt[(vcu * NWAVES + w2) * 8 + lane]; }
    if (vcu == 0 && tid < 8) ((int*)(ws + WS_SMALL + SM_ETOT))[tid] = tt[tid];
    const int NGW = G * NWAVES, gw = vcu * NWAVES + wave, RPW = (M + NGW - 1) / NGW;
    for (int ib = 0; ib < RPW; ib += 4) {
        int te4[4]; v4u v4[4][2];
#pragma unroll
        for (int k = 0; k < 4; ++k) { const int rc = min(gw * RPW + ib + k, M - 1); te4[k] = tok_e[rc]; const v4u* s = (const v4u*)(hn + (size_t)rc * DM) + lane; v4[k][0] = s[0]; v4[k][1] = s[64]; }
#pragma unroll
        for (int k = 0; k < 4; ++k) {
            const int row = gw * RPW + ib + k; if (ib + k >= RPW || row >= M) break;
            const int i0 = te4[k] & 0xff, i1 = te4[k] >> 8;
            const int p0 = __shfl(run, i0); if (lane == i0) ++run;
            const int p1 = __shfl(run, i1); if (lane == i1) ++run;
            if (lane == 0) { pos[2 * row] = p0; pos[2 * row + 1] = p1; }
            v4u* d0 = (v4u*)(xp + (size_t)p0 * DM) + lane; v4u* d1 = (v4u*)(xp + (size_t)p1 * DM) + lane;
            d0[0] = v4[k][0]; d1[0] = v4[k][0]; d0[64] = v4[k][1]; d1[64] = v4[k][1];
        }
    }
    __syncthreads();
}

static __device__ __noinline__ void combine_phase(LAS unsigned char* lds, int lane, int wave, int vcu, int G) {
    unsigned char* ws = ARGWS_G(); const float* nw = ARGF_G(I_NFIN); float* out = ARGOUT();
    const float* hA = (const float*)(ws + WS_HA); const bf16* Y = (const bf16*)(ws + WS_Y); const float* YT = (const float*)(ws + WS_YT);
    const int* pos = (const int*)(ws + WS_SMALL + SM_POS); const f32x2* tok_g = (const f32x2*)(ws + WS_SMALL + SM_TOKG); const int* tok_e = (const int*)(ws + WS_SMALL + SM_TOKE);
    const LAS int* stb = (const LAS int*)(lds + SCHED_OFF);
    const int nfull = stb[80], S = stb[81];
    const int NGW = G * NWAVES, gw = vcu * NWAVES + wave;
    int p0n, p1n, ten; f32x2 ggn;
    { const int rc = min(gw, M - 1); p0n = pos[2 * rc]; p1n = pos[2 * rc + 1]; ggn = tok_g[rc]; ten = tok_e[rc]; }
    for (int row = gw; row < M; row += NGW) {
        const int p0 = p0n, p1 = p1n; const f32x2 gg = ggn;
        const int te = ten, e0 = te & 0xff, e1 = te >> 8;
        { const int rc = min(row + NGW, M - 1); p0n = pos[2 * rc]; p1n = pos[2 * rc + 1]; ggn = tok_g[rc]; ten = tok_e[rc]; }
        const int w0b = stb[48 + e0] + (p0 >> 8) - stb[40 + e0], m0 = stb[32 + e0], w1b = stb[48 + e1] + (p1 >> 8) - stb[40 + e1], m1 = stb[32 + e1];
        f32x4 x[8]; v2u ya[8], yb[8]; float ss = 0.f;
#pragma unroll
        for (int j = 0; j < 8; ++j) { const int o = 4 * lane + 256 * j;
            ya[j] = *(const v2u*)(Y + (size_t)p0 * DM + o); yb[j] = *(const v2u*)(Y + (size_t)p1 * DM + o);
            { const v2u t = *(const v2u*)((const bf16*)hA + (size_t)row * DM + o); x[j] = (f32x4){bflo(t.x), bfhi(t.x), bflo(t.y), bfhi(t.y)}; } }
#pragma unroll
        for (int j = 0; j < 8; ++j) {
            f32x4 y0 = (f32x4){bflo(ya[j].x), bfhi(ya[j].x), bflo(ya[j].y), bfhi(ya[j].y)}, y1 = (f32x4){bflo(yb[j].x), bfhi(yb[j].x), bflo(yb[j].y), bfhi(yb[j].y)};
            const int w0 = w0b + j * m0, w1 = w1b + j * m1;
            if (w0 >= nfull) { y0 = (f32x4){0.f, 0.f, 0.f, 0.f}; for (int kp = 0; kp < S; ++kp) y0 += *(const f32x4*)(YT + ((size_t)((w0 - nfull) * S + kp) * 256 + (p0 & 255)) * 256 + 4 * lane); }
            if (w1 >= nfull) { y1 = (f32x4){0.f, 0.f, 0.f, 0.f}; for (int kp = 0; kp < S; ++kp) y1 += *(const f32x4*)(YT + ((size_t)((w1 - nfull) * S + kp) * 256 + (p1 & 255)) * 256 + 4 * lane); }
            x[j] += gg[0] * y0 + gg[1] * y1;
            ss += (x[j][0] * x[j][0] + x[j][1] * x[j][1]) + (x[j][2] * x[j][2] + x[j][3] * x[j][3]); }
        ss = wave_sum(ss);
        const float rstd = 1.0f / sqrtf(ss * (1.0f / DM) + EPS);
#pragma unroll
        for (int j = 0; j < 8; ++j) { const int o = 4 * lane + 256 * j; *(f32x4*)(out + (size_t)row * DM + o) = x[j] * rstd * *(const f32x4*)(nw + o); }
    }
}

static __device__ __noinline__ void kmean_unit(LAS unsigned char* lds, int tid, int u, const bf16* __restrict__ P, float* __restrict__ kmean) {
    const int h = u & 7, blk = (u >> 3) % 7, b = u / 56;
    const bf16* Kp = P + (size_t)(b * SEQ + blk * 256) * NP + PC_K + h * 128;
    const int c = tid & 15, rg = tid >> 4;
    float s[8];
#pragma unroll
    for (int e = 0; e < 8; ++e) s[e] = 0.f;
#pragma unroll
    for (int r = 0; r < 8; ++r) { const v4u v = *(const v4u*)(Kp + (size_t)(rg * 8 + r) * NP + c * 8);
        s[0] += bflo(v.x); s[1] += bfhi(v.x); s[2] += bflo(v.y); s[3] += bfhi(v.y); s[4] += bflo(v.z); s[5] += bfhi(v.z); s[6] += bflo(v.w); s[7] += bfhi(v.w); }
    LAS float* red = (LAS float*)lds;
#pragma unroll
    for (int e = 0; e < 8; ++e) red[rg * 128 + c * 8 + e] = s[e];
    __syncthreads();
    if (tid < 128) { float t = 0.f;
#pragma unroll 8
        for (int r = 0; r < 32; ++r) t += red[r * 128 + tid];
        kmean[(size_t)((b * 8 + h) * 8 + blk) * 128 + tid] = t * (1.0f / 256.0f); }
    __syncthreads();
}

template <int NT>
__device__ __forceinline__ void conv_load(const bf16* __restrict__ Pc, int t0, int seqpos0, const float* __restrict__ cw, const float* __restrict__ cb, unsigned (&raw)[NT + 3], f32x2 (&w)[4], f32x2& bb) {
#pragma unroll
    for (int j = 0; j < 4; ++j) w[j] = *(const f32x2*)(cw + j * 1024);
    bb = *(const f32x2*)cb;
#pragma unroll
    for (int i = 0; i < NT + 3; ++i) { const int t = t0 - 3 + i; const bool ok = seqpos0 + t >= 0; const unsigned v = *(const unsigned*)(Pc + (ptrdiff_t)(ok ? t : -seqpos0) * NP); raw[i] = ok ? v : 0u; }
}
template <int NT>
__device__ __forceinline__ void conv_apply(const unsigned (&raw)[NT + 3], const f32x2 (&w)[4], const f32x2 bb, float (&o0)[NT], float (&o1)[NT]) {
#pragma unroll
    for (int i = 0; i < NT; ++i) { float a0 = bb[0], a1 = bb[1];
#pragma unroll
        for (int j = 0; j < 4; ++j) { a0 += w[j][0] * bflo(raw[i + j]); a1 += w[j][1] * bfhi(raw[i + j]); }
        o0[i] = siluf_(a0); o1[i] = siluf_(a1); }
}

static __device__ __noinline__ void ssd1_unit(LAS unsigned char* lds, int tid, int lane, int wave, int u, int layer) {
    unsigned char* ws = ARGWS_G(); const float* scw = ARGF_G(I_SCW) + (size_t)layer * 4096; const float* scb = ARGF_G(I_SCB) + layer * 1024;
    const int h = u & 7, c = (u >> 3) & 15, b = u >> 7, g = h >> 2;
    const int row0 = b * SEQ + c * 128;
    const bf16* P = (const bf16*)(ws + WS_P); float* XC = (float*)(ws + WS_XC);
    const float* DT = (const float*)(ws + WS_SMALL + SM_DT); float* LAC = (float*)(ws + WS_SMALL + SM_LAC); float* DEC = (float*)(ws + WS_SMALL + SM_DEC); float* ST = (float*)(ws + WS_ST);
    LAS float* wgl = (LAS float*)lds;
    LAS unsigned char* xT = lds + 2048;
    LAS unsigned char* BT = xT + 17408;
    const bool doC = (h & 3) == 1;
    const int cpx = tid & 31, runx = tid >> 5, chx = h * 64 + 2 * cpx, t0x = runx * 8;
    const int cpb = tid & 63, runb = tid >> 6, chb = 512 + g * 128 + 2 * cpb, t0b = runb * 16;
    const int chc = 768 + g * 128 + 2 * cpb;
    unsigned rx[11], rb[19], rc[19]; f32x2 wx[4], wb[4], wc4[4]; f32x2 bx2, bb2, bc2;
    conv_load<8>(P + (size_t)row0 * NP + PC_X + chx, t0x, c * 128, scw + chx, scb + chx, rx, wx, bx2);
    conv_load<16>(P + (size_t)row0 * NP + PC_X + chb, t0b, c * 128, scw + chb, scb + chb, rb, wb, bb2);
    if (doC) conv_load<16>(P + (size_t)row0 * NP + PC_X + chc, t0b, c * 128, scw + chc, scb + chc, rc, wc4, bc2);
    if (wave == 0) {
        const float a = -expf(ARGF_G(I_SALOG)[layer * 8 + h]);
        const float d0 = DT[(size_t)(row0 + 2 * lane) * 8 + h], d1 = DT[(size_t)(row0 + 2 * lane + 1) * 8 + h];
        const float l0 = d0 * a, l1 = d1 * a;
        float sc = l0 + l1;
#pragma unroll
        for (int o = 1; o < 64; o <<= 1) { const float t = __shfl_up(sc, o); if (lane >= o) sc += t; }
        const float c1 = sc, c0 = sc - l1, tot = __shfl(sc, 63);
        wgl[2 * lane] = d0 * expf(tot - c0); wgl[2 * lane + 1] = d1 * expf(tot - c1);
        LAC[(size_t)(row0 + 2 * lane) * 8 + h] = c0; LAC[(size_t)(row0 + 2 * lane + 1) * 8 + h] = c1;
        if (lane == 0) DEC[(b * 16 + c) * 8 + h] = expf(tot);
    }
    __syncthreads();
    {
        float o0[8], o1[8];
        conv_apply<8>(rx, wx, bx2, o0, o1);
#pragma unroll
        for (int i = 0; i < 8; ++i) { const int t = t0x + i; *(f32x2*)(XC + (size_t)(row0 + t) * 1024 + chx) = (f32x2){o0[i], o1[i]};
            const float wg = wgl[t];
            *(LAS bf16*)(xT + (2 * cpx) * 272 + t * 2) = (bf16)f2bf(o0[i] * wg); *(LAS bf16*)(xT + (2 * cpx + 1) * 272 + t * 2) = (bf16)f2bf(o1[i] * wg); }
    }
    {
        float o0[16], o1[16];
        conv_apply<16>(rb, wb, bb2, o0, o1);
        const bool st = (h & 3) == 0;
#pragma unroll
        for (int i = 0; i < 16; ++i) { const int t = t0b + i; if (st) *(f32x2*)(XC + (size_t)(row0 + t) * 1024 + chb) = (f32x2){o0[i], o1[i]};
            *(LAS bf16*)(BT + (2 * cpb) * 272 + t * 2) = (bf16)f2bf(o0[i]); *(LAS bf16*)(BT + (2 * cpb + 1) * 272 + t * 2) = (bf16)f2bf(o1[i]); }
    }
    if (doC) {
        float o0[16], o1[16];
        conv_apply<16>(rc, wc4, bc2, o0, o1);
#pragma unroll
        for (int i = 0; i < 16; ++i) *(f32x2*)(XC + (size_t)(row0 + t0b + i) * 1024 + chc) = (f32x2){o0[i], o1[i]};
    }
    __syncthreads();
    {
        float* Sp = ST + (size_t)((b * 16 + c) * 8 + h) * 64 * 128;
#pragma unroll
        for (int pt = 0; pt < 4; ++pt) {
            f32x4 acc = {0.f, 0.f, 0.f, 0.f};
            acc = mma_lds<128>(acc, xT + pt * 16 * 272, 272, BT + wave * 16 * 272, 272, lane);
#pragma unroll
            for (int r = 0; r < 4; ++r) Sp[(size_t)(pt * 16 + 4 * (lane >> 4) + r) * 128 + wave * 16 + (lane & 15)] = acc[r];
        }
    }
    __syncthreads();
}

static __device__ __noinline__ void cf_unit(LAS unsigned char* lds, int tid, int lane, int wave, int u, int layer) {
    unsigned char* ws = ARGWS_G(); const float* ccw = ARGF_G(I_CCW) + (size_t)layer * 31 * 512; const float* ccb = ARGF_G(I_CCB) + layer * 512; const float* clw = ARGF_G(I_CLW) + layer * 512; const float* clb = ARGF_G(I_CLB) + layer * 512;
    const bf16* P = (const bf16*)(ws + WS_P); bf16* MIX = (bf16*)(ws + WS_MIX);
    const int row0 = u * 32, tseq0 = row0 & (SEQ - 1), c = tid;
    LAS float* ul = (LAS float*)lds;
    {
        v4u av[8], gv[8];
#pragma unroll
        for (int k = 0; k < 8; ++k) { const int it = tid + 512 * k, i = it >> 6, cg = (it & 63) * 8; const int ri = (tseq0 - 30 + i >= 0) ? (row0 - 30 + i) : row0;
            const bf16* pr = P + (size_t)ri * NP + PC_G + cg; av[k] = (it < 62 * 64) ? *(const v4u*)pr : (v4u){0u, 0u, 0u, 0u}; gv[k] = (it < 62 * 64) ? *(const v4u*)(pr + 512) : (v4u){0u, 0u, 0u, 0u}; }
#pragma unroll
        for (int k = 0; k < 8; ++k) { const int it = tid + 512 * k, i = it >> 6, cg = (it & 63) * 8;
            if (it < 62 * 64) {
                const float z = (tseq0 - 30 + i >= 0) ? 1.0f : 0.0f;
                const f32x4 u0 = (f32x4){bflo(av[k].x) * sigmoidf_(bflo(gv[k].x)), bfhi(av[k].x) * sigmoidf_(bfhi(gv[k].x)), bflo(av[k].y) * sigmoidf_(bflo(gv[k].y)), bfhi(av[k].y) * sigmoidf_(bfhi(gv[k].y))} * z;
                const f32x4 u1 = (f32x4){bflo(av[k].z) * sigmoidf_(bflo(gv[k].z)), bfhi(av[k].z) * sigmoidf_(bfhi(gv[k].z)), bflo(av[k].w) * sigmoidf_(bflo(gv[k].w)), bfhi(av[k].w) * sigmoidf_(bfhi(gv[k].w))} * z;
                *(LAS f32x4*)(ul + i * 512 + cg) = u0; *(LAS f32x4*)(ul + i * 512 + cg + 4) = u1; } }
    }
    float wt[31];
#pragma unroll
    for (int j = 0; j < 31; ++j) wt[j] = ccw[j * 512 + c];
    const float bias = ccb[c];
    __syncthreads();
    float uu[62];
#pragma unroll
    for (int i = 0; i < 62; ++i) uu[i] = ul[i * 512 + c];
    float o[32];
#pragma unroll
    for (int i = 0; i < 32; ++i) o[i] = bias;
#pragma unroll
    for (int j = 0; j < 31; ++j) {
#pragma unroll
        for (int i = 0; i < 32; ++i) o[i] += wt[j] * uu[i + j]; }
    __syncthreads();
    LAS float* ol = (LAS float*)lds;
#pragma unroll
    for (int i = 0; i < 32; ++i) ol[i * 512 + c] = o[i];
    __syncthreads();
    const f32x4 lw0 = *(const f32x4*)(clw + 8 * lane), lw1 = *(const f32x4*)(clw + 8 * lane + 4), lb0 = *(const f32x4*)(clb + 8 * lane), lb1 = *(const f32x4*)(clb + 8 * lane + 4);
#pragma unroll
    for (int tt = 0; tt < 4; ++tt) {
        const int i = 4 * wave + tt;
        const f32x4 a = *(const LAS f32x4*)(ol + i * 512 + 8 * lane), bq = *(const LAS f32x4*)(ol + i * 512 + 8 * lane + 4);
        const float mu = wave_sum((a[0] + a[1]) + (a[2] + a[3]) + (bq[0] + bq[1]) + (bq[2] + bq[3])) * (1.0f / 512.0f);
        const f32x4 da = a - mu, db = bq - mu;
        const float var = wave_sum((da[0] * da[0] + da[1] * da[1]) + (da[2] * da[2] + da[3] * da[3]) + (db[0] * db[0] + db[1] * db[1]) + (db[2] * db[2] + db[3] * db[3])) * (1.0f / 512.0f);
        const float rstd = 1.0f / sqrtf(var + EPS);
        const f32x4 ha = da * rstd * lw0 + lb0, hb = db * rstd * lw1 + lb1;
        v4u w; w.x = pk2(siluf_(ha[0]), siluf_(ha[1])); w.y = pk2(siluf_(ha[2]), siluf_(ha[3])); w.z = pk2(siluf_(hb[0]), siluf_(hb[1])); w.w = pk2(siluf_(hb[2]), siluf_(hb[3]));
        *(v4u*)(MIX + (size_t)(row0 + i) * DM + 1536 + 8 * lane) = w;
    }
    __syncthreads();
}

__device__ __forceinline__ void ssd_scan(LAS unsigned char* lds, int tid, int vcu, int G) {
    unsigned char* ws = ARGWS_G();
    const float* ST = (const float*)(ws + WS_ST); const float* DEC = (const float*)(ws + WS_SMALL + SM_DEC); bf16* PREV = (bf16*)(ws + WS_ACT);
    for (int item = vcu; item < 256; item += G) {
        const int b = item >> 6, head = (item >> 3) & 7, pc = item & 7;
        if (tid < 256) {
            const int p = pc * 8 + (tid >> 5), n0 = (tid & 31) * 4;
            f32x4 st[16]; float dec[16];
#pragma unroll
            for (int c = 0; c < 16; ++c) { st[c] = *(const f32x4*)(ST + ((size_t)((b * 16 + c) * 8 + head) * 64 + p) * 128 + n0); dec[c] = DEC[(b * 16 + c) * 8 + head]; }
            f32x4 sacc = {0.f, 0.f, 0.f, 0.f};
#pragma unroll
            for (int c = 0; c < 16; ++c) { v2u w; w.x = pk2(sacc[0], sacc[1]); w.y = pk2(sacc[2], sacc[3]);
                *(v2u*)(PREV + ((size_t)((b * 16 + c) * 8 + head) * 64 + p) * 128 + n0) = w; sacc = sacc * dec[c] + st[c]; }
        }
    }
}

static __device__ __noinline__ void ssd2_part1(LAS unsigned char* lds, int tid, int lane, int wave, int u, int layer) {
    unsigned char* ws = ARGWS_G(); const float* sdp = ARGF_G(I_SD) + layer * 8; const float* snw = ARGF_G(I_SNW) + layer * 512;
    const int half = u & 1, g = (u >> 1) & 1, c = (u >> 2) & 15, b = u >> 6;
    const int row0 = b * SEQ + c * 128, tb = half * 64, SL = tb + 64;
    const bf16* P = (const bf16*)(ws + WS_P); bf16* MIX = (bf16*)(ws + WS_MIX); const float* XC = (const float*)(ws + WS_XC); float* YZ = (float*)(ws + WS_YZ);
    const float* DT = (const float*)(ws + WS_SMALL + SM_DT); const float* LAC = (const float*)(ws + WS_SMALL + SM_LAC); const bf16* PREV = (const bf16*)(ws + WS_ACT);
    LAS unsigned char* Cb = lds;
    LAS unsigned char* Bb = lds + 17408;
    LAS unsigned char* xsT = Bb;
    LAS unsigned char* prv = Bb + 17408;
    LAS float* Gf = (LAS float*)(lds + 52224);
    LAS unsigned char* Mh = lds + 85248;
    LAS float* dts = (LAS float*)(lds + 102656);
    LAS float* lcs = (LAS float*)(lds + 104704);
    LAS float* ssq = (LAS float*)(lds + 106752);
    const int q16 = lane & 15, gq = lane >> 4;
    {
        const int rr = tid >> 3, n0 = (tid & 7) * 16;
        f32x4 lc[4], lb0[4], lb1[4];
        { const float* src = XC + (size_t)(row0 + tb + rr) * 1024 + 768 + g * 128 + n0;
#pragma unroll
          for (int q = 0; q < 4; ++q) lc[q] = *(const f32x4*)(src + 4 * q); }
        { const float* src = XC + (size_t)(row0 + rr) * 1024 + 512 + g * 128 + n0;
#pragma unroll
          for (int q = 0; q < 4; ++q) { lb0[q] = *(const f32x4*)(src + 4 * q); lb1[q] = *(const f32x4*)(src + (size_t)64 * 1024 + 4 * q); } }
        const float ldt = DT[(size_t)(row0 + (tid >> 2)) * 8 + g * 4 + (tid & 3)], llc = LAC[(size_t)(row0 + (tid >> 2)) * 8 + g * 4 + (tid & 3)];
#define SSD2_PK(W0, W1, V) do { W0.x = pk2(V[0][0], V[0][1]); W0.y = pk2(V[0][2], V[0][3]); W0.z = pk2(V[1][0], V[1][1]); W0.w = pk2(V[1][2], V[1][3]); \
                                W1.x = pk2(V[2][0], V[2][1]); W1.y = pk2(V[2][2], V[2][3]); W1.z = pk2(V[3][0], V[3][1]); W1.w = pk2(V[3][2], V[3][3]); } while (0)
        { v4u w0, w1; SSD2_PK(w0, w1, lc); *(LAS v4u*)(Cb + rr * 272 + n0 * 2) = w0; *(LAS v4u*)(Cb + rr * 272 + n0 * 2 + 16) = w1; }
        { v4u w0, w1; SSD2_PK(w0, w1, lb0); *(LAS v4u*)(Bb + rr * 272 + n0 * 2) = w0; *(LAS v4u*)(Bb + rr * 272 + n0 * 2 + 16) = w1; }
        if (SL > 64) { v4u w0, w1; SSD2_PK(w0, w1, lb1); *(LAS v4u*)(Bb + (rr + 64) * 272 + n0 * 2) = w0; *(LAS v4u*)(Bb + (rr + 64) * 272 + n0 * 2 + 16) = w1; }
#undef SSD2_PK
        if (tid < SL * 4) { dts[tid] = ldt; lcs[tid] = llc; }
        if (tid < 64) ssq[tid] = 0.f;
    }
    __syncthreads();
    if (16 * wave < SL) {
#pragma unroll
        for (int tt = 0; tt < 4; ++tt) { f32x4 acc = {0.f, 0.f, 0.f, 0.f};
            acc = mma_lds<128>(acc, Cb + tt * 16 * 272, 272, Bb + wave * 16 * 272, 272, lane);
#pragma unroll
            for (int r = 0; r < 4; ++r) Gf[(tt * 16 + 4 * gq + r) * 129 + 16 * wave + q16] = acc[r]; }
    }
    __syncthreads();
}
static __device__ __noinline__ void ssd2_head(LAS unsigned char* lds, int tid, int lane, int wave, int u, int layer, int hh) {
    unsigned char* ws = ARGWS(); const float* sdp = ARGF(I_SD) + layer * 8; const float* snw = ARGF(I_SNW) + layer * 512;
    const int half = u & 1, g = (u >> 1) & 1, c = (u >> 2) & 15, b = u >> 6;
    const int row0 = b * SEQ + c * 128, tb = half * 64, SL = tb + 64;
    const bf16* P = (const bf16*)(ws + WS_P); bf16* MIX = (bf16*)(ws + WS_MIX); const float* XC = (const float*)(ws + WS_XC); float* YZ = (float*)(ws + WS_YZ);
    const float* DT = (const float*)(ws + WS_SMALL + SM_DT); const float* LAC = (const float*)(ws + WS_SMALL + SM_LAC); const bf16* PREV = (const bf16*)(ws + WS_ACT);
    LAS unsigned char* Cb = lds;
    LAS unsigned char* Bb = lds + 17408;
    LAS unsigned char* xsT = Bb;
    LAS unsigned char* prv = Bb + 17408;
    LAS float* Gf = (LAS float*)(lds + 52224);
    LAS unsigned char* Mh = lds + 85248;
    LAS float* dts = (LAS float*)(lds + 102656);
    LAS float* lcs = (LAS float*)(lds + 104704);
    LAS float* ssq = (LAS float*)(lds + 106752);
    const int q16 = lane & 15, gq = lane >> 4;
    float ssl[4] = {0.f, 0.f, 0.f, 0.f};
    const int tw = wave >> 1;
        const int head = g * 4 + hh;
        const int pq_ = tid >> 3, nq_ = (tid & 7) * 16;
        const bf16* sp_ = PREV + ((size_t)((b * 16 + c) * 8 + head) * 64 + pq_) * 128 + nq_;
        const v4u pw0 = *(const v4u*)sp_, pw1 = *(const v4u*)(sp_ + 8);
        const int sx_ = tid >> 2, px_ = (tid & 3) * 16, sxc_ = sx_ < SL ? sx_ : SL - 1;
        const float* xsrc_ = XC + (size_t)(row0 + sxc_) * 1024 + head * 64 + px_;
        f32x4 xq_[4];
#pragma unroll
        for (int q = 0; q < 4; ++q) xq_[q] = *(const f32x4*)(xsrc_ + 4 * q);
        const float Dh = sdp[head];
        float xv_[2][4]; unsigned zw_[2][4];
#pragma unroll
        for (int q2 = 0; q2 < 2; ++q2)
#pragma unroll
            for (int r = 0; r < 4; ++r) { const int tl = tb + (wave >> 1) * 16 + 4 * gq + r, p = (2 * (wave & 1) + q2) * 16 + q16;
                xv_[q2][r] = XC[(size_t)(row0 + tl) * 1024 + head * 64 + p]; zw_[q2][r] = P[(size_t)(row0 + tl) * NP + PC_Z + head * 64 + p]; }
        *(LAS v4u*)(prv + pq_ * 272 + nq_ * 2) = pw0; *(LAS v4u*)(prv + pq_ * 272 + nq_ * 2 + 16) = pw1;
        if (sx_ < SL) {
#pragma unroll
            for (int q = 0; q < 4; ++q)
#pragma unroll
                for (int e = 0; e < 4; ++e) *(LAS bf16*)(xsT + (px_ + 4 * q + e) * 272 + sx_ * 2) = (bf16)f2bf(xq_[q][e]); }
        {
            const int t = tid >> 3, s0 = (tid & 7) * 16;
            if (s0 < SL) { const float lt = lcs[(tb + t) * 4 + hh]; unsigned w[8];
                float gv[16], lv[16], dv[16];
#pragma unroll
                for (int q = 0; q < 16; ++q) { gv[q] = Gf[t * 129 + s0 + q]; lv[q] = lcs[(s0 + q) * 4 + hh]; dv[q] = dts[(s0 + q) * 4 + hh]; }
#pragma unroll
                for (int q = 0; q < 8; ++q) { float v2[2];
#pragma unroll
                    for (int e = 0; e < 2; ++e) { const int s = s0 + 2 * q + e; const float val = gv[2 * q + e] * fexp(fminf(lt - lv[2 * q + e], 0.f)) * dv[2 * q + e]; v2[e] = (s <= tb + t) ? val : 0.f; }
                    w[q] = pk2(v2[0], v2[1]); }
                v4u w0, w1; w0.x = w[0]; w0.y = w[1]; w0.z = w[2]; w0.w = w[3]; w1.x = w[4]; w1.y = w[5]; w1.z = w[6]; w1.w = w[7];
                *(LAS v4u*)(Mh + t * 272 + s0 * 2) = w0; *(LAS v4u*)(Mh + t * 272 + s0 * 2 + 16) = w1; }
        }
        __syncthreads();
#pragma unroll
        for (int q2 = 0; q2 < 2; ++q2) {
            const int pp = 2 * (wave & 1) + q2;
            f32x4 yd = {0.f, 0.f, 0.f, 0.f}, yo = {0.f, 0.f, 0.f, 0.f};
            if (half) yd = mma_lds<128>(yd, Mh + tw * 16 * 272, 272, xsT + pp * 16 * 272, 272, lane);
            else yd = mma_lds<64>(yd, Mh + tw * 16 * 272, 272, xsT + pp * 16 * 272, 272, lane);
            yo = mma_lds<128>(yo, Cb + tw * 16 * 272, 272, prv + pp * 16 * 272, 272, lane);
#pragma unroll
            for (int r = 0; r < 4; ++r) {
                const int tl = tb + tw * 16 + 4 * gq + r, p = pp * 16 + q16;
                const float e = fexp(lcs[tl * 4 + hh]), xv = xv_[q2][r];
                const float y = yd[r] + e * yo[r] + Dh * xv;
                const float z = bf2f(zw_[q2][r]);
                const float v = y * siluf_(z);
                ssl[r] += v * v;
                YZ[(size_t)(row0 + tl) * 512 + head * 64 + p] = v;
            }
        }
        __syncthreads();
    LAS float* ssp = (LAS float*)(lds + 107008);
#pragma unroll
    for (int r = 0; r < 4; ++r) { float s = row16_sum(ssl[r]);
        if (q16 == 0) ssp[(hh * 2 + (wave & 1)) * 64 + tw * 16 + 4 * gq + r] = s; }
}
static __device__ __noinline__ void ssd2_finish(LAS unsigned char* lds, int tid, int lane, int wave, int u, int layer) {
    unsigned char* ws = ARGWS_G(); const float* sdp = ARGF_G(I_SD) + layer * 8; const float* snw = ARGF_G(I_SNW) + layer * 512;
    const int half = u & 1, g = (u >> 1) & 1, c = (u >> 2) & 15, b = u >> 6;
    const int row0 = b * SEQ + c * 128, tb = half * 64, SL = tb + 64;
    const bf16* P = (const bf16*)(ws + WS_P); bf16* MIX = (bf16*)(ws + WS_MIX); const float* XC = (const float*)(ws + WS_XC); float* YZ = (float*)(ws + WS_YZ);
    const float* DT = (const float*)(ws + WS_SMALL + SM_DT); const float* LAC = (const float*)(ws + WS_SMALL + SM_LAC); const bf16* PREV = (const bf16*)(ws + WS_ACT);
    LAS unsigned char* Cb = lds;
    LAS unsigned char* Bb = lds + 17408;
    LAS unsigned char* xsT = Bb;
    LAS unsigned char* prv = Bb + 17408;
    LAS float* Gf = (LAS float*)(lds + 52224);
    LAS unsigned char* Mh = lds + 85248;
    LAS float* dts = (LAS float*)(lds + 102656);
    LAS float* lcs = (LAS float*)(lds + 104704);
    LAS float* ssq = (LAS float*)(lds + 106752);
    const int q16 = lane & 15, gq = lane >> 4;
    const int tw = wave >> 1;
    const LAS float* ssp = (const LAS float*)(lds + 107008);
    __syncthreads();
    float vz[4][4][2], sw[4][2];
#pragma unroll
    for (int hh = 0; hh < 4; ++hh)
#pragma unroll
        for (int q2 = 0; q2 < 2; ++q2) { const int ch = g * 256 + hh * 64 + (2 * (wave & 1) + q2) * 16 + q16; sw[hh][q2] = snw[ch];
#pragma unroll
            for (int r = 0; r < 4; ++r) vz[hh][r][q2] = YZ[(size_t)(row0 + tb + tw * 16 + 4 * gq + r) * 512 + ch]; }
#pragma unroll
    for (int r = 0; r < 4; ++r) {
        const int t = tw * 16 + 4 * gq + r; float sq = 0.f;
#pragma unroll
        for (int k = 0; k < 8; ++k) sq += ssp[k * 64 + t];
        const float rstd = 1.0f / sqrtf(sq * (1.0f / 256.0f) + EPS);
#pragma unroll
        for (int hh = 0; hh < 4; ++hh)
#pragma unroll
            for (int q2 = 0; q2 < 2; ++q2) { const int ch = g * 256 + hh * 64 + (2 * (wave & 1) + q2) * 16 + q16;
                MIX[(size_t)(row0 + tb + t) * DM + 1024 + ch] = (bf16)f2bf(vz[hh][r][q2] * rstd * sw[hh][q2]); }
    }
    __syncthreads();
}

__device__ __forceinline__ void attn_tile(LAS unsigned char* lds, int tid, int lane, int wave, int b, int h, int t) {
    asm volatile("" : "+v"(tid), "+v"(lane));
    unsigned char* ws = (unsigned char*)ldarg_g(lds, 24);
    const bf16* P = (const bf16*)(ws + WS_P); bf16* MIX = (bf16*)(ws + WS_MIX); const float* kmean = (const float*)(ws + WS_SMALL + SM_KMEAN);
    const int i = t >> 1, hf = t & 1, q16 = lane & 15, gq = lane >> 4;
    const int qi = hf * 128 + 16 * wave + q16;
    const size_t qrow = (size_t)b * SEQ + i * 256 + qi;
    LAS float* kml = (LAS float*)(lds + 71680);
    for (int x = tid; x < 7 * 128; x += 512) kml[x] = kmean[(size_t)((b * 8 + h) * 8) * 128 + x];
    bf16x8 Qf[4];
#pragma unroll
    for (int ks = 0; ks < 4; ++ks) Qf[ks] = *(const bf16x8*)(P + qrow * NP + PC_Q + h * 128 + 32 * ks + 8 * gq);
    const int n_own = hf ? 4 : 2, n_it = n_own + 4 * i;
    v4u pk[2], pv[2];
#define TILE_ROWS(it) ((size_t)b * SEQ + ((it) < n_own ? i : (((it) - n_own) >> 2)) * 256 + ((it) < n_own ? (it) : (((it) - n_own) & 3)) * 64)
    {
        const size_t kr = TILE_ROWS(0);
#pragma unroll
        for (int e = 0; e < 2; ++e) { const int x = tid + 512 * e, key = x >> 4, c16 = x & 15; const bf16* src = P + (kr + key) * NP + h * 128 + c16 * 8; pk[e] = *(const v4u*)(src + PC_K); pv[e] = *(const v4u*)(src + PC_V); }
    }
    __syncthreads();
    unsigned sel;
    if (i <= 3) sel = (1u << i) - 1u;
    else {
        float gate[7];
#pragma unroll
        for (int j = 0; j < 7; ++j) { float s = 0.f;
            if (j < i) {
#pragma unroll
                for (int ks = 0; ks < 4; ++ks) { const f32x4 ka = *(const LAS f32x4*)(kml + j * 128 + 32 * ks + 8 * gq), kb = *(const LAS f32x4*)(kml + j * 128 + 32 * ks + 8 * gq + 4);
                    const bf16x8 qv = Qf[ks];
                    s += bf2f((unsigned short)qv[0]) * ka[0] + bf2f((unsigned short)qv[1]) * ka[1] + bf2f((unsigned short)qv[2]) * ka[2] + bf2f((unsigned short)qv[3]) * ka[3]
                       + bf2f((unsigned short)qv[4]) * kb[0] + bf2f((unsigned short)qv[5]) * kb[1] + bf2f((unsigned short)qv[6]) * kb[2] + bf2f((unsigned short)qv[7]) * kb[3]; }
            }
            s = xrow_sum(s); gate[j] = s; }
        sel = 0u;
#pragma unroll
        for (int rep = 0; rep < 3; ++rep) { float best = -INFINITY; int bj = 0;
#pragma unroll
            for (int j = 0; j < 7; ++j) if (j < i && !((sel >> j) & 1u) && gate[j] > best) { best = gate[j]; bj = j; }
            sel |= 1u << bj; }
    }
    {
#pragma unroll
        for (int e = 0; e < 2; ++e) { const int x = tid + 512 * e, key = x >> 4, c16 = x & 15; *(LAS v4u*)(lds + key * 272 + c16 * 16) = pk[e]; *(LAS v4u*)(lds + 17408 + key * 288 + c16 * 16) = pv[e]; }
    }
    __syncthreads();
    f32x4 O[8];
#pragma unroll
    for (int d = 0; d < 8; ++d) O[d] = (f32x4){0.f, 0.f, 0.f, 0.f};
    float mrun = -1e30f, lrun = 0.f;
    v4u pk1[2], pv1[2];
#define ATT_LOAD(PK, PV, TILE) do { const size_t kr_ = TILE_ROWS(TILE); _Pragma("unroll") for (int e = 0; e < 2; ++e) { const int x = tid + 512 * e, key = x >> 4, c16 = x & 15; \
        const bf16* src = P + (kr_ + key) * NP + h * 128 + c16 * 8; PK[e] = *(const v4u*)(src + PC_K); PV[e] = *(const v4u*)(src + PC_V); } } while (0)
#define ATT_STORE(PK, PV, BUF) do { LAS unsigned char* Kn_ = lds + (BUF) * 35840; _Pragma("unroll") for (int e = 0; e < 2; ++e) { const int x = tid + 512 * e, key = x >> 4, c16 = x & 15; \
        *(LAS v4u*)(Kn_ + key * 272 + c16 * 16) = PK[e]; *(LAS v4u*)(Kn_ + 17408 + key * 288 + c16 * 16) = PV[e]; } } while (0)
    if (n_it > 1) ATT_LOAD(pk1, pv1, 1);
#pragma unroll 1
    for (int it0 = 0; it0 < n_it; it0 += 2) {
#pragma unroll
      for (int par = 0; par < 2; ++par) {
        const int it = it0 + par, buf = par;
        if (it + 2 < n_it) { if (par == 0) ATT_LOAD(pk, pv, it + 2); else ATT_LOAD(pk1, pv1, it + 2); }
        const bool own = it < n_own; const int blk = own ? i : ((it - n_own) >> 2), kt = own ? it : ((it - n_own) & 3);
        const bool skip = own && (kt * 64 > hf * 128 + 16 * wave + 15);
        if (!skip) {
            const LAS unsigned char* Kl = lds + buf * 35840; const LAS unsigned char* Vl = Kl + 17408;
            f32x4 s[4];
            {
                bf16x8 kf[4][4];
#pragma unroll
                for (int T = 0; T < 4; ++T)
#pragma unroll
                    for (int ks = 0; ks < 4; ++ks) kf[T][ks] = *(const LAS bf16x8*)(Kl + (16 * T + q16) * 272 + ks * 64 + gq * 16);
                __builtin_amdgcn_sched_barrier(0);
#pragma unroll
                for (int T = 0; T < 4; ++T) { s[T] = __builtin_amdgcn_mfma_f32_16x16x32_bf16(kf[T][0], Qf[0], (f32x4){0.f, 0.f, 0.f, 0.f}, 0, 0, 0);
#pragma unroll
                    for (int ks = 1; ks < 4; ++ks) s[T] = __builtin_amdgcn_mfma_f32_16x16x32_bf16(kf[T][ks], Qf[ks], s[T], 0, 0, 0); }
                __builtin_amdgcn_sched_barrier(0);
            }
            if (own) {
#pragma unroll
                for (int T = 0; T < 4; ++T)
#pragma unroll
                    for (int r = 0; r < 4; ++r) if (kt * 64 + 16 * T + 4 * gq + r > qi) s[T][r] = -INFINITY;
            } else {
                const float bias = ((sel >> blk) & 1u) ? 0.f : -INFINITY;
#pragma unroll
                for (int T = 0; T < 4; ++T) s[T] += bias;
            }
            float mx = -INFINITY;
#pragma unroll
            for (int T = 0; T < 4; ++T) mx = fmaxf(mx, fmaxf(fmaxf(s[T][0], s[T][1]), fmaxf(s[T][2], s[T][3])));
            mx = xrow_max(mx);
            const float mnew = fmaxf(mrun, mx), alpha = __builtin_amdgcn_exp2f(mrun - mnew);
            mrun = mnew;
            float rs = 0.f;
#pragma unroll
            for (int T = 0; T < 4; ++T)
#pragma unroll
                for (int r = 0; r < 4; ++r) { const float p = __builtin_amdgcn_exp2f(s[T][r] - mnew); s[T][r] = p; rs += p; }
            rs = xrow_sum(rs);
            lrun = lrun * alpha + rs;
#pragma unroll
            for (int d = 0; d < 8; ++d) O[d] *= alpha;
#pragma unroll
            for (int k2 = 0; k2 < 2; ++k2) {
                bf16x8 pb; { const unsigned w0 = pg8::cvt_pk_bf16(s[2 * k2][0], s[2 * k2][1]), w1 = pg8::cvt_pk_bf16(s[2 * k2][2], s[2 * k2][3]), w2 = pg8::cvt_pk_bf16(s[2 * k2 + 1][0], s[2 * k2 + 1][1]), w3 = pg8::cvt_pk_bf16(s[2 * k2 + 1][2], s[2 * k2 + 1][3]);
                    const v4u wv = {w0, w1, w2, w3}; pb = __builtin_bit_cast(bf16x8, wv); }
                s16x4 v0[8], v1[8];
#pragma unroll
                for (int d = 0; d < 8; ++d) {
                    const LAS unsigned char* va0 = Vl + (32 * k2 + 4 * gq + (q16 >> 2)) * 288 + (16 * d + 4 * (q16 & 3)) * 2;
                    v0[d] = __builtin_amdgcn_ds_read_tr16_b64_v4i16((LAS s16x4*)va0);
                    v1[d] = __builtin_amdgcn_ds_read_tr16_b64_v4i16((LAS s16x4*)(va0 + 16 * 288));
                }
                __builtin_amdgcn_sched_barrier(0);
#pragma unroll
                for (int d = 0; d < 8; ++d) {
                    const bf16x8 va = {v0[d][0], v0[d][1], v0[d][2], v0[d][3], v1[d][0], v1[d][1], v1[d][2], v1[d][3]};
                    O[d] = __builtin_amdgcn_mfma_f32_16x16x32_bf16(va, pb, O[d], 0, 0, 0);
                }
                __builtin_amdgcn_sched_barrier(0);
            }
        }
        if (it + 1 < n_it) { if (par == 0) ATT_STORE(pk1, pv1, 1); else ATT_STORE(pk, pv, 0); }
        __syncthreads();
      }
    }
#undef ATT_LOAD
#undef ATT_STORE
    const float inv = 1.0f / lrun;
#pragma unroll
    for (int d = 0; d < 8; ++d) { v2u w; w.x = pk2(O[d][0] * inv, O[d][1] * inv); w.y = pk2(O[d][2] * inv, O[d][3] * inv);
        *(v2u*)(MIX + qrow * DM + h * 128 + 16 * d + 4 * gq) = w; }
    __syncthreads();
}

template <class Sched>
__device__ __forceinline__ void rs_table(LAS unsigned char* lds, unsigned char* ws, const Sched& S, int tid) {
    volatile LAS int* pml = (volatile LAS int*)(lds + RS_OFF - 16);
    if (tid == 0) { int n = 0; pml[0] = -1; pml[1] = -1; pml[2] = -1; pml[3] = -1; pg8::Unit uu;
        for (int i = 0; S.next(i, uu); ++i) { bool f = false; for (int k = 0; k < n; ++k) f |= (pml[k] == uu.pm); if (!f && n < 4) { pml[n] = uu.pm; ++n; } } }
    __syncthreads();
    const float* ssp = (const float*)(ws + WS_SMALL + SM_SS); LAS float* rst = (LAS float*)(lds + RS_OFF);
    int pmv[4]; f32x4 av[4][4];
#pragma unroll
    for (int sl = 0; sl < 4; ++sl) { pmv[sl] = pml[sl]; const int row = tid >> 1, hf = tid & 1;
        const GAS f32x4* p4 = (const GAS f32x4*)((const GAS float*)ssp + ((size_t)(max(pmv[sl], 0) * 256 + row) * 32 + hf * 16));
#pragma unroll
        for (int q = 0; q < 4; ++q) av[sl][q] = p4[q]; }
#pragma unroll
    for (int sl = 0; sl < 4; ++sl) { const int row = tid >> 1, hf = tid & 1;
        const f32x4 a0 = av[sl][0], a1 = av[sl][1], a2 = av[sl][2], a3 = av[sl][3];
        float sacc = ((a0[0] + a0[1]) + (a0[2] + a0[3])) + ((a1[0] + a1[1]) + (a1[2] + a1[3])) + ((a2[0] + a2[1]) + (a2[2] + a2[3])) + ((a3[0] + a3[1]) + (a3[2] + a3[3]));
        sacc += __shfl_xor(sacc, 1);
        if (hf == 0 && pmv[sl] >= 0) rst[sl * 256 + row] = 1.0f / sqrtf(sacc * (1.0f / DM) + EPS); }
    __syncthreads();
}

__global__ void __launch_bounds__(NWAVES * 64, 2) fwd_kernel(Args args) {
    extern __shared__ __attribute__((aligned(16))) unsigned char lds_raw[];
    LAS unsigned char* lds = (LAS unsigned char*)lds_raw;
    const int tid = threadIdx.x, lane = tid & 63, wave = __builtin_amdgcn_readfirstlane(tid >> 6);
    const int G = gridDim.x; const int bx = blockIdx.x; const int vcu = (G % 8 == 0) ? (bx % 8) * (G / 8) + bx / 8 : bx;
    volatile LAS unsigned* MISC = (volatile LAS unsigned*)(lds + MISC_OFF);
    for (int u = tid; u < (LDS_BYTES - MISC_OFF) / 4; u += NWAVES * 64) ((LAS unsigned*)(lds + MISC_OFF))[u] = 0u;
    __syncthreads();
    if (tid == 0) {
        LAS unsigned long long* at = (LAS unsigned long long*)(lds + ARGS_OFF);
#pragma unroll
        for (int k = 0; k < 23; ++k) at[k] = (unsigned long long)args.in[k];
        at[23] = (unsigned long long)args.out; at[24] = (unsigned long long)args.ws;
    }
    __syncthreads();
    static_assert(WS_CTL == 0 && CW_BAR == 4096 && MISC_OFF == 131072 && ARGS_OFF == 131072 + 1024, "grid_barrier() hard-codes these");
    if (!MK_PER_PHASE) { const XcdBarrier b0 = xcd_barrier_post((unsigned*)(ARGWS() + WS_CTL) + CW_BAR, MISC); if (tid == 0) MISC[2] = b0.x; __syncthreads(); }
    const int lo = args.ph_lo, hi = args.ph_hi;
#define IN(k) (lo <= (k) && (k) < hi)
#define NREP(k) (((PROBE_MASK >> (k)) & 1u) ? 2 : 1)
#define SEAM(k) do { if (!MK_PER_PHASE && IN(k) && ((k) + 1 < hi || rep_ + 1 < NREP(k))) grid_barrier(lds); } while (0)
    volatile LAS int* stb = (volatile LAS int*)(lds + SCHED_OFF);

#pragma unroll 1
    for (int rep_ = 0; rep_ < NREP(0); ++rep_) if (IN(0)) { p0_prologue(lds, tid, lane, wave, vcu, G); __syncthreads(); if (rep_ + 1 < NREP(0)) grid_barrier(lds); }

#pragma unroll 1
    for (int layer = 0; layer < 2; ++layer) {
        const int pb = 1 + 10 * layer;
        const bool moe = (layer & 1) != 0;

#pragma unroll 1
        for (int rep_ = 0; rep_ < NREP(pb + 0); ++rep_) if (layer == 0 && IN(pb + 0)) {
            unsigned char* ws = ARGWS();
            const float* hin = layer == 0 ? ARGF(I_X) : (const float*)(ws + WS_HB);
            norm_phase<0>(lds, tid, lane, wave, vcu, G, hin, ARGF(I_NMIX) + layer * DM, (bf16*)(ws + WS_HN), ARGF(I_WIN) + (size_t)layer * DM * IN_DIM + 4608, IN_DIM,
                          ARGF(I_SDTB) + layer * 8, (float*)(ws + WS_SMALL + SM_DT), nullptr, nullptr, nullptr, nullptr);
            SEAM(pb + 0);
        }
#pragma unroll 1
        for (int rep_ = 0; rep_ < NREP(pb + 1); ++rep_) if (IN(pb + 1)) {
            unsigned char* ws = ARGWS();
            pg8::Gemm g{(const bf16*)(ws + (layer ? WS_HB : WS_HN)), (const bf16*)(ws + WS_WIN) + (size_t)layer * NP * DM, M, NP, DM};     pg8::StaticOrder S; S.init(M, layer ? NP + 256 : NP, G, bx);
            pg8::EpiInproj E{(bf16*)(ws + WS_P), NP, (const float*)(ws + WS_ROPE), 0.08838834764831845f * 1.4426950408889634f, layer ? (const LAS unsigned char*)(lds + RS_OFF) : nullptr};
            if (layer) rs_table(lds, ws, S, tid);
            const bool cvA = ((bx >> 3) & 1) == 0; const int cvw = (((bx >> 4) << 3) | (bx & 7)) * NWAVES + wave, cvh = (G * NWAVES) >> 1;
            constexpr int IT_E1 = IT_IN + (IT_EARLY - IT_IN) / 2;
            if (layer == 0 && rep_ == 0 && cvA) { cv_run(lds, lds + wave * 16384, lane, IT_IN + cvw, cvh, IT_E1); __syncthreads(); }
            pg8::gemm_phase<pg8::EpiInproj, pg8::StaticOrder, true, true>(lds, g, S, E);
            if (layer == 0 && rep_ == 0 && !cvA) { __syncthreads(); cv_run(lds, lds + wave * 16384, lane, IT_E1 + cvw, cvh, IT_EARLY); __syncthreads(); }
            SEAM(pb + 1);
        }
#pragma unroll 1
        for (int rep_ = 0; rep_ < NREP(pb + 2); ++rep_) if (IN(pb + 2)) {
            for (int r2 = 0; r2 < (PROBE_SUB == 3 ? 2 : 1); ++r2)
            for (int u = vcu; u < 224; u += G) kmean_unit(lds, tid, u, (const bf16*)(ARGWS() + WS_P), (float*)(ARGWS() + WS_SMALL + SM_KMEAN));
            for (int r2 = 0; r2 < (PROBE_SUB == 4 ? 2 : 1); ++r2)
            for (int u = vcu; u < 512; u += G) ssd1_unit(lds, tid, lane, wave, u, layer);
            for (int r2 = 0; r2 < (PROBE_SUB == 5 ? 2 : 1); ++r2)
            for (int u = vcu; u < 256; u += G) cf_unit(lds, tid, lane, wave, u, layer);
            SEAM(pb + 2);
        }
#pragma unroll 1
        for (int rep_ = 0; rep_ < NREP(pb + 3); ++rep_) if (IN(pb + 3)) {
            ssd_scan(lds, tid, vcu, G); grid_barrier(lds);
            for (int r2 = 0; r2 < (PROBE_SUB == 1 ? 2 : 1); ++r2)
            for (int u = vcu; u < 256; u += G) { const int b = u >> 6, h = (u >> 3) & 7, pi = u & 7;
#pragma unroll 1
                for (int tt = 0; tt < 2; ++tt) attn_tile(lds, tid, lane, wave, b, h, tt ? 15 - pi : pi); }
            for (int r2 = 0; r2 < (PROBE_SUB == 2 ? 2 : 1); ++r2)
            for (int u = vcu; u < 256; u += G) { ssd2_part1(lds, tid, lane, wave, u, layer); for (int hh = 0; hh < 4; ++hh) ssd2_head(lds, tid, lane, wave, u, layer, hh); ssd2_finish(lds, tid, lane, wave, u, layer); }
            SEAM(pb + 3);
        }
#pragma unroll 1
        for (int rep_ = 0; rep_ < NREP(pb + 4); ++rep_) if (IN(pb + 4)) {
            unsigned char* ws = ARGWS();
            const float* hin = layer == 0 ? ARGF(I_X) : (const float*)(ws + WS_HB);
            pg8::Gemm g{(const bf16*)(ws + WS_MIX), (const bf16*)(ws + WS_WOUT) + (size_t)layer * DM * DM, M, DM, DM}; pg8::StaticOrder S; S.init(M, DM, G, bx);
            pg8::EpiRes E{hin, (float*)(ws + WS_HA), moe ? DM : -DM, 1.0f, nullptr};
            pg8::gemm_phase<pg8::EpiRes, pg8::StaticOrder, false, true>(lds, g, S, E);
            SEAM(pb + 4);
        }
#pragma unroll 1
        for (int rep_ = 0; rep_ < NREP(pb + 5); ++rep_) if (moe && IN(pb + 5)) {
            unsigned char* ws = ARGWS();
            norm_phase<1>(lds, tid, lane, wave, vcu, G, (const float*)(ws + WS_HA), ARGF(I_NFFN) + layer * DM, (bf16*)(ws + WS_HN8), ARGF(I_RT) + (size_t)(layer >> 1) * DM * NE, NE, nullptr, nullptr,
                               (int*)(ws + WS_SMALL + SM_TOKE), (f32x2*)(ws + WS_SMALL + SM_TOKG), (int*)(ws + WS_SMALL + SM_WCNT), (int*)(ws + WS_SMALL + SM_BCNT));
            SEAM(pb + 5);
        }
#pragma unroll 1
        for (int rep_ = 0; rep_ < NREP(pb + 6); ++rep_) if (moe && IN(pb + 6)) { gather_phase(lds, tid, lane, wave, vcu, G); SEAM(pb + 6); }
        if (IN(pb + 7) || IN(pb + 8)) {
            __syncthreads();
            if (tid == 0) {
                if (!moe) { stb[0] = 4; for (int g2 = 0; g2 < 4; ++g2) { stb[32 + g2] = 8; stb[40 + g2] = 8 * g2; } }
                else { const GAS int* et = (const GAS int*)(ARGWS_G() + WS_SMALL + SM_ETOT); typedef int i32x4_ __attribute__((ext_vector_type(4)));
                    const i32x4_ ea = *(const GAS i32x4_*)et, eb = *(const GAS i32x4_*)(et + 4);
                    stb[0] = 8; int mb = 0;
#pragma unroll
                    for (int e = 0; e < 8; ++e) { const int mt = ((e < 4 ? ea[e & 3] : eb[e & 3]) + 255) >> 8; stb[32 + e] = mt; stb[40 + e] = mb; mb += mt; } }
            }
            __syncthreads();
        }
#pragma unroll 1
        for (int rep_ = 0; rep_ < NREP(pb + 7); ++rep_) if (IN(pb + 7)) {
            if (tid == 0) { const int ng = stb[0]; int cum = 0; for (int g2 = 0; g2 < ng; ++g2) { stb[48 + g2] = cum; cum += stb[32 + g2] * 56; stb[64 + g2] = (moe ? g2 : 0) * 56; } stb[48 + ng] = cum; stb[80] = cum; stb[81] = 1; }
            __syncthreads();
            unsigned char* ws = ARGWS();
            pg8::GroupOrder S; S.tb = (const LAS int*)stb; S.G = G; S.c = bx; S.nwg = __builtin_amdgcn_readfirstlane(stb[48 + stb[0]]);
            if (!moe) {
                const bool cvFirst = ((bx >> 3) & 1) == 0; const int half = (G * NWAVES) >> 1;
                const int cw = (((bx >> 4) << 3) | (bx & 7)) * NWAVES + wave;
                constexpr int IT_MID = IT_EARLY + 4 * IT_FF;
                if (cvFirst && rep_ == 0) { cv_run(lds, lds + wave * 16384, lane, IT_EARLY + cw, half, IT_MID); __syncthreads(); }
                rs_table(lds, ws, S, tid);
                pg8::Gemm g{(const bf16*)(ws + WS_HN8), (const bf16*)(ws + WS_WGU), 0, 0, DM / 2};
                pg8::EpiSwiglu8 E{ws + WS_ACT, DFF, 0.0078125f, 0.0078125f, true, (const LAS unsigned char*)(lds + RS_OFF)};
                pg8::gemm_phase<pg8::EpiSwiglu8, pg8::GroupOrder, true, true, true>(lds, g, S, E);
                if (!cvFirst && rep_ == 0) { __syncthreads(); cv_run(lds, lds + wave * 16384, lane, IT_MID + cw, half, IT_TOTAL); __syncthreads(); }
            } else {
                pg8::Gemm g{(const bf16*)(ws + WS_XP8), (const bf16*)(ws + WS_WGU8), 0, 0, DM / 2};
                pg8::EpiSwiglu8 E{ws + WS_ACT8, DFF, 0.0078125f, 0.0625f, false, nullptr};
                pg8::gemm_phase<pg8::EpiSwiglu8, pg8::GroupOrder, true, true, true>(lds, g, S, E);
            }
            SEAM(pb + 7);
        }
#pragma unroll 1
        for (int rep_ = 0; rep_ < NREP(pb + 8); ++rep_) if (IN(pb + 8)) {
            __syncthreads();
            if (tid == 0) { const int ng = stb[0]; int cum = 0; for (int g2 = 0; g2 < ng; ++g2) { stb[48 + g2] = cum; cum += stb[32 + g2] * 8; stb[64 + g2] = (moe ? g2 : 0) * 8; } stb[48 + ng] = cum;
                const int R = cum % G; int S = 1; if (moe && cum > G && R > 0) { if (4 * R <= G) S = 4; else if (2 * R <= G) S = 2; }
                stb[80] = S > 1 ? cum - R : cum; stb[81] = S; }
            __syncthreads();
            unsigned char* ws = ARGWS();
            pg8::GroupOrder S; S.tb = (const LAS int*)stb; S.G = G; S.c = bx; { const int tot = stb[48 + stb[0]], nf = stb[80]; S.nwg = __builtin_amdgcn_readfirstlane(nf + (tot - nf) * stb[81]); }
            if (!moe) {
                pg8::Gemm g{(const bf16*)(ws + WS_ACT), (const bf16*)(ws + WS_WDN), 0, 0, DFF};
                pg8::EpiRes E{(const float*)(ws + WS_HA), (float*)(ws + WS_HB), -(DM + 1), 1.0f, nullptr};
                pg8::gemm_phase<pg8::EpiRes, pg8::GroupOrder, false, true, false>(lds, g, S, E);
            } else {
                pg8::Gemm g{(const bf16*)(ws + WS_ACT8), (const bf16*)(ws + WS_WDN8), 0, 0, DFF / 2};
                pg8::EpiRes E{nullptr, (float*)(ws + WS_YT), DM, 1.0f / 1024.0f, (bf16*)(ws + WS_Y)};
                pg8::gemm_phase<pg8::EpiRes, pg8::GroupOrder, false, true, true>(lds, g, S, E);
            }
            SEAM(pb + 8);
        }
#pragma unroll 1
        for (int rep_ = 0; rep_ < NREP(pb + 9); ++rep_) if (moe && IN(pb + 9)) { combine_phase(lds, lane, wave, vcu, G); if (rep_ + 1 < NREP(pb + 9)) grid_barrier(lds); }
    }
#undef IN
#undef SEAM
}

extern "C" void kernel_launch(void* const* d_in, const int* in_sizes, int n_in, void* d_out, int out_size, void* d_ws, size_t ws_size, hipStream_t stream) {
    static int grid = 0;
    if (grid == 0) {
        if (n_in != 23 || out_size != M * DM || ws_size < WS_END) { fprintf(stderr, "kernel_launch: unexpected problem (n_in %d, out %d, ws %zu < %zu)\n", n_in, out_size, ws_size, (size_t)WS_END); grid = -1; return; }
        int dev = 0, cus = 0, per_cu = 0;
        if (hipGetDevice(&dev) != hipSuccess || hipDeviceGetAttribute(&cus, hipDeviceAttributeMultiprocessorCount, dev) != hipSuccess) { grid = -1; return; }
        if (hipFuncSetAttribute((const void*)fwd_kernel, hipFuncAttributeMaxDynamicSharedMemorySize, LDS_BYTES) != hipSuccess) { fprintf(stderr, "kernel_launch: hipFuncSetAttribute failed\n"); grid = -1; return; }
        if (hipOccupancyMaxActiveBlocksPerMultiprocessor(&per_cu, (const void*)fwd_kernel, NWAVES * 64, LDS_BYTES) != hipSuccess || per_cu < 1) fprintf(stderr, "kernel_launch: occupancy query reports %d\n", per_cu);
        (void)hipGetLastError();
        grid = cus;
    }
    if (grid < 0) return;
    if (hipMemsetAsync((char*)d_ws + WS_CTL, 0, CTL_ZERO_BYTES, stream) != hipSuccess) return;
    Args a{};
    for (int i = 0; i < 23; ++i) a.in[i] = (const float*)d_in[i];
    a.out = (float*)d_out; a.ws = (unsigned char*)d_ws;
#if MK_PER_PHASE
    for (int ph = 0; ph < 21; ++ph) {
        if (ph == 7 || ph == 10) continue;
        a.ph_lo = ph; a.ph_hi = ph + 1;
        hipLaunchKernelGGL(fwd_kernel, dim3(grid), dim3(NWAVES * 64), LDS_BYTES, stream, a);
    }
#else
    a.ph_lo = 0; a.ph_hi = 21;
    hipLaunchKernelGGL(fwd_kernel, dim3(grid), dim3(NWAVES * 64), LDS_BYTES, stream, a);
#endif
}
```

```cpp
#include <hip/hip_runtime.h>
#include <cstdio>
#include <cstdint>

#ifndef PROBE_MASK
#define PROBE_MASK 0u
#endif
#define PROBE_SUB 0
#ifndef MK_PER_PHASE
#define MK_PER_PHASE 0
#endif

constexpr int DM = 2048, NBATCH = 4, SEQ = 2048, M = NBATCH * SEQ;
constexpr int IN_DIM = 5640, NP = 5632;
constexpr int DFF = 7168, NE = 8, MPMAX = 72 * 256;
constexpr int NWAVES = 8;
constexpr float EPS = 1e-5f;
constexpr int PC_Q = 0, PC_K = 1024, PC_V = 2048, PC_Z = 3072, PC_X = 3584, PC_G = 4608;

constexpr size_t MiB = 1u << 20;
constexpr size_t WS_CTL = 0, CTL_ZERO_BYTES = 32 * 1024;
constexpr size_t WS_ROPE = 1 * MiB;
constexpr size_t WS_SMALL = 2 * MiB;
constexpr size_t WS_WIN = 4 * MiB;
constexpr size_t WS_WOUT = WS_WIN + 45 * MiB;
constexpr size_t WS_WGU = WS_WOUT + 16 * MiB;
constexpr size_t WS_WGU8 = WS_WGU + 56 * MiB;
constexpr size_t WS_WDN = WS_WGU8 + 224 * MiB;
constexpr size_t WS_WDN8 = WS_WDN + 28 * MiB;
constexpr size_t WS_HA = WS_WDN8 + 112 * MiB;
constexpr size_t WS_HB = WS_HA + 64 * MiB;
constexpr size_t WS_HN = WS_HB + 64 * MiB;
constexpr size_t WS_P = WS_HN + 32 * MiB;
constexpr size_t WS_MIX = WS_P + 88 * MiB;
constexpr size_t WS_ACT = WS_MIX + 32 * MiB;
constexpr size_t WS_YT = WS_ACT + 16 * MiB;
constexpr size_t WS_ACT8 = WS_ACT + 112 * MiB;
constexpr size_t WS_XP8 = WS_ACT8 + 126 * MiB;
constexpr size_t WS_HN8 = WS_XP8 + 36 * MiB;
constexpr size_t WS_Y = WS_HN8 + 16 * MiB;
constexpr size_t WS_XC = WS_Y + 144 * MiB;
constexpr size_t WS_ST = WS_XC + 32 * MiB;
constexpr size_t WS_YZ = WS_ST + 16 * MiB;
constexpr size_t WS_END = WS_YZ + 16 * MiB;
static_assert(WS_END <= 1792 * MiB, "d_ws map must fit 4 x the largest input tensor (1792 MiB)");
constexpr size_t SM_DT = 0;
constexpr size_t SM_LAC = 256 * 1024;
constexpr size_t SM_DEC = 512 * 1024;
constexpr size_t SM_KMEAN = 520 * 1024;
constexpr size_t SM_TOKE = 656 * 1024;
constexpr size_t SM_TOKG = 688 * 1024;
constexpr size_t SM_POS = 752 * 1024;
constexpr size_t SM_WCNT = 816 * 1024;
constexpr size_t SM_BCNT = 880 * 1024;
constexpr size_t SM_ETOT = 888 * 1024;
constexpr size_t SM_NWC = 896 * 1024;
constexpr size_t SM_SS = 1024 * 1024;
constexpr int RS_OFF = 131072 + 4096;
constexpr int CW_BAR = 4096;
constexpr int RING_BYTES = 131072, MISC_OFF = 131072, SCHED_OFF = MISC_OFF + 256, LDS_BYTES = 147456;

namespace pg8 {
#define PG8_LAS __attribute__((address_space(3)))
#define PG8_GAS __attribute__((address_space(1)))
typedef unsigned short bf16_t;
typedef short bf16x8 __attribute__((ext_vector_type(8)));
typedef float f32x4 __attribute__((ext_vector_type(4)));
typedef unsigned u32x4 __attribute__((ext_vector_type(4)));
constexpr int BM = 256, BK = 64, HALF = 128, HTB = HALF * BK * 2, STAGE_BYTES = 8 * HTB, NXCD = 8, WGM = 8;

__host__ __device__ __forceinline__ int lds_byte(int r, int c) { const int st = (r >> 4) * 2 + (c >> 5), rr = r & 15, cc = c & 31, ob = rr * 64 + cc * 2; return st * 1024 + (ob ^ (((ob >> 9) & 1) << 5)); }
__host__ __device__ __forceinline__ void stage_rc(int b, int& R, int& C) { const int st = b / 1024, sb = b % 1024, swz = sb ^ (((sb >> 9) & 1) << 5); R = (st >> 1) * 16 + swz / 64; C = (st & 1) * 32 + (swz % 64) / 2; }
__host__ __device__ __forceinline__ int perm32(int rho) { const int n = rho >> 4, i = rho & 15; return 8 * (i >> 2) + 4 * n + (i & 3); }

struct Unit { int pm, pn, pnl, sk; __device__ __forceinline__ int kp() const { return sk & 0xff; } __device__ __forceinline__ int ks() const { return (sk >> 8) & 0xff; } __device__ __forceinline__ int tl() const { return (sk >> 16) - 1; } };
struct Gemm { const bf16_t* A; const bf16_t* Bt; int M, N, K; };

struct StaticOrder {
    int nM, nN, nwg, G, c;
    __device__ void init(int M, int N, int G_, int c_) { nM = M / BM; nN = N / BM; nwg = nM * nN; G = G_; c = c_; }
    __device__ __forceinline__ bool next(int i, Unit& u) const {
        const long L = (long)i * G + c; if (L >= nwg) return false;
        int wgid = (int)L; { const int q = nwg / NXCD, r = nwg % NXCD, xcd = wgid % NXCD, off = wgid / NXCD; wgid = (xcd < r ? xcd * (q + 1) : r * (q + 1) + (xcd - r) * q) + off; }
        const int nig = WGM * nN, gid = wgid / nig, fm = gid * WGM, gsz = (nM - fm) < WGM ? (nM - fm) : WGM;
        u.pm = fm + ((wgid % nig) % gsz); u.pn = (wgid % nig) / gsz; u.pnl = u.pn; u.sk = 0x100; return true;
    }
    __device__ __forceinline__ void a_ready(const Unit&) const {}
    __device__ __forceinline__ void done(const Unit&) const {}
};
struct GroupOrder {
    const PG8_LAS int* tb; int G, c, nwg;
    __device__ __forceinline__ bool next(int i, Unit& u) const {
        const long L = (long)i * G + c; if (L >= nwg) return false;
        const int nfull = tb[80], S = tb[81]; int kp = 0, tl = -1;
        int wgid = (int)L;
        if (wgid < nfull) { const int q = nfull / NXCD, r = nfull % NXCD, xcd = wgid % NXCD, off = wgid / NXCD; wgid = (xcd < r ? xcd * (q + 1) : r * (q + 1) + (xcd - r) * q) + off; }
        else { const int v = wgid - nfull; tl = v / S; kp = v - tl * S; wgid = nfull + tl; }
        const int ng = tb[0]; int g = 0;
        for (int k = 1; k < 8; ++k) if (k < ng && wgid >= tb[48 + k]) g = k;
        const int r = wgid - tb[48 + g], mt = tb[32 + g], pnl = r / mt, pm = tb[40 + g] + (r - pnl * mt);
        u.pm = __builtin_amdgcn_readfirstlane(pm); u.pnl = __builtin_amdgcn_readfirstlane(pnl); u.pn = __builtin_amdgcn_readfirstlane(tb[64 + g] + pnl);
        u.sk = __builtin_amdgcn_readfirstlane(kp | ((tl >= 0 ? S : 1) << 8) | ((tl + 1) << 16)); return true;
    }
    __device__ __forceinline__ void a_ready(const Unit&) const {}
    __device__ __forceinline__ void done(const Unit&) const {}
};

__device__ __forceinline__ float xrow_sum4(float v) {
    { const unsigned x = __builtin_bit_cast(unsigned, v); const auto r = __builtin_amdgcn_permlane32_swap(x, x, false, false); v = __builtin_bit_cast(float, (unsigned)r[0]) + __builtin_bit_cast(float, (unsigned)r[1]); }
    { const unsigned x = __builtin_bit_cast(unsigned, v); const auto r = __builtin_amdgcn_permlane16_swap(x, x, false, false); v = __builtin_bit_cast(float, (unsigned)r[0]) + __builtin_bit_cast(float, (unsigned)r[1]); }
    return v; }
__device__ __forceinline__ unsigned cvt_pk_bf16(float lo, float hi) { unsigned r; asm volatile("v_cvt_pk_bf16_f32 %0, %1, %2" : "=v"(r) : "v"(lo), "v"(hi)); return r; }

struct EpiInproj {
    static constexpr bool PERM = true, AFTER_DRAIN = false;
    bf16_t* O; int ldc; const float* rope; float qscale;
    const PG8_LAS unsigned char* rsb;
    __device__ __forceinline__ void operator()(const f32x4 (&acc)[2][2][4][2], const Unit& u, int wr, int wc, int fr, int fq) const {
        const int row0 = u.pm * BM + wr * 64 + fr;
        const PG8_LAS float* rst = nullptr;
        if (rsb) { const PG8_LAS int* pml = (const PG8_LAS int*)(rsb - 16); const int sl = pml[0] == u.pm ? 0 : (pml[1] == u.pm ? 1 : (pml[2] == u.pm ? 2 : 3));
            rst = (const PG8_LAS float*)rsb + sl * 256 + wr * 64 + fr; }
        if (u.pn == 22) {
            if (wc == 0 && fq == 0) {
                unsigned char* wsb = (unsigned char*)O - WS_P; const float* bia = (const float*)(wsb + WS_SMALL + SM_NWC) + 2 * DM; float* dto = (float*)(wsb + WS_SMALL + SM_DT);
                const f32x4 b0 = *(const f32x4*)bia, b1 = *(const f32x4*)(bia + 4);
#pragma unroll
                for (int ai = 0; ai < 2; ++ai)
#pragma unroll
                    for (int m = 0; m < 4; ++m) { const float r = rst[ai * HALF + m * 16]; f32x4 x0 = acc[ai][0][m][0] * r + b0, x1 = acc[ai][0][m][1] * r + b1;
#pragma unroll
                        for (int j = 0; j < 4; ++j) { x0[j] = fmaxf(x0[j], 0.f) + 0.6931471805599453f * __builtin_amdgcn_logf(1.0f + __builtin_amdgcn_exp2f(-1.4426950408889634f * __builtin_fabsf(x0[j])));
                                                      x1[j] = fmaxf(x1[j], 0.f) + 0.6931471805599453f * __builtin_amdgcn_logf(1.0f + __builtin_amdgcn_exp2f(-1.4426950408889634f * __builtin_fabsf(x1[j]))); }
                        float* dp = dto + (size_t)(row0 + ai * HALF + m * 16) * 8; *(f32x4*)dp = x0; *(f32x4*)(dp + 4) = x1; }
            }
            return;
        }
        if (u.pn < 8) {
            const int part = u.pn >> 2, pl = u.pn & 3, head = 2 * pl + (wc >> 1), dlo = (wc & 1) * 32 + 8 * fq;
            const float sc0 = part == 0 ? qscale : 1.0f;
            const PG8_GAS float* grope = (const PG8_GAS float*)rope; PG8_GAS bf16_t* gO = (PG8_GAS bf16_t*)O;
            f32x4 rq[2][4];
#define PG8_RP_LD(G, D) do { const int pos_ = (row0 + ((G) >> 2) * HALF + ((G) & 3) * 16) & 2047; _Pragma("unroll") for (int q_ = 0; q_ < 4; ++q_) D[q_] = *(const PG8_GAS f32x4*)(grope + ((size_t)pos_ * 64 + dlo) * 2 + 4 * q_); } while (0)
            PG8_RP_LD(0, rq[0]);
#pragma unroll
            for (int g = 0; g < 8; ++g) { const int ai = g >> 2, m = g & 3;
                {
                    if (g + 1 < 8) PG8_RP_LD(g + 1, rq[(g + 1) & 1]);
                    const float sc = rsb ? sc0 * rst[ai * HALF + m * 16] : sc0;
                    const int row = row0 + ai * HALF + m * 16;
                    u32x4 w1, w2; unsigned o1[4], o2[4];
#pragma unroll
                    for (int n = 0; n < 2; ++n) {
                        const f32x4 cs0 = rq[g & 1][2 * n], cs1 = rq[g & 1][2 * n + 1];
                        const f32x4 x1 = acc[ai][0][m][n], x2 = acc[ai][1][m][n];
                        const float a0 = (x1[0] * cs0[0] - x2[0] * cs0[1]) * sc, a1 = (x1[1] * cs0[2] - x2[1] * cs0[3]) * sc;
                        const float a2 = (x1[2] * cs1[0] - x2[2] * cs1[1]) * sc, a3 = (x1[3] * cs1[2] - x2[3] * cs1[3]) * sc;
                        const float b0 = (x2[0] * cs0[0] + x1[0] * cs0[1]) * sc, b1 = (x2[1] * cs0[2] + x1[1] * cs0[3]) * sc;
                        const float b2 = (x2[2] * cs1[0] + x1[2] * cs1[1]) * sc, b3 = (x2[3] * cs1[2] + x1[3] * cs1[3]) * sc;
                        o1[2 * n] = cvt_pk_bf16(a0, a1); o1[2 * n + 1] = cvt_pk_bf16(a2, a3);
                        o2[2 * n] = cvt_pk_bf16(b0, b1); o2[2 * n + 1] = cvt_pk_bf16(b2, b3);
                    }
                    w1.x = o1[0]; w1.y = o1[1]; w1.z = o1[2]; w1.w = o1[3]; w2.x = o2[0]; w2.y = o2[1]; w2.z = o2[2]; w2.w = o2[3];
                    PG8_GAS bf16_t* rowp = gO + (size_t)row * ldc + part * 1024 + head * 128 + dlo;
                    *(PG8_GAS u32x4*)rowp = w1; *(PG8_GAS u32x4*)(rowp + 64) = w2;
                }
            }
        } else {
            const int col0 = u.pn * BM + wc * 32 + 8 * fq;
#pragma unroll
            for (int ai = 0; ai < 2; ++ai)
#pragma unroll
                for (int m = 0; m < 4; ++m) { PG8_GAS bf16_t* rowp = (PG8_GAS bf16_t*)O + (size_t)(row0 + ai * HALF + m * 16) * ldc + col0; const float r = rsb ? rst[ai * HALF + m * 16] : 1.0f;
#pragma unroll
                    for (int bj = 0; bj < 2; ++bj) { const f32x4 v0 = acc[ai][bj][m][0] * r, v1 = acc[ai][bj][m][1] * r;
                        u32x4 w; w.x = cvt_pk_bf16(v0[0], v0[1]); w.y = cvt_pk_bf16(v0[2], v0[3]); w.z = cvt_pk_bf16(v1[0], v1[1]); w.w = cvt_pk_bf16(v1[2], v1[3]);
                        *(PG8_GAS u32x4*)(rowp + bj * HALF) = w; } }
        }
    }
};
struct EpiSwiglu {
    static constexpr bool PERM = true, AFTER_DRAIN = false;
    bf16_t* O; int ldc;
    __device__ __forceinline__ void operator()(const f32x4 (&acc)[2][2][4][2], const Unit& u, int wr, int wc, int fr, int fq) const {
        const int row0 = u.pm * BM + wr * 64 + fr, col0 = u.pnl * HALF + wc * 32 + 8 * fq;
#pragma unroll
        for (int ai = 0; ai < 2; ++ai)
#pragma unroll
            for (int m = 0; m < 4; ++m) {
                float v[8];
#pragma unroll
                for (int n = 0; n < 2; ++n)
#pragma unroll
                    for (int j = 0; j < 4; ++j) { const float g = acc[ai][0][m][n][j], up = acc[ai][1][m][n][j];
                        v[4 * n + j] = g * __builtin_amdgcn_rcpf(1.0f + __builtin_amdgcn_exp2f(-1.4426950408889634f * g)) * up; }
                u32x4 w; w.x = cvt_pk_bf16(v[0], v[1]); w.y = cvt_pk_bf16(v[2], v[3]); w.z = cvt_pk_bf16(v[4], v[5]); w.w = cvt_pk_bf16(v[6], v[7]);
                *(u32x4*)(O + (size_t)(row0 + ai * HALF + m * 16) * ldc + col0) = w;
            }
    }
};
struct EpiSwiglu8 {
    static constexpr bool PERM = true, AFTER_DRAIN = false;
    unsigned char* O; int ldc; float gsc, usc;
    bool o16;
    const PG8_LAS unsigned char* rsb;
    __device__ __forceinline__ void operator()(const f32x4 (&acc)[2][2][4][2], const Unit& u, int wr, int wc, int fr, int fq) const {
        const int row0 = u.pm * BM + wr * 64 + fr, col0 = u.pnl * HALF + wc * 32 + 8 * fq;
        const float esc0 = -1.4426950408889634f * gsc, psc0 = gsc * usc;
        const PG8_LAS float* rst = nullptr;
        if (rsb) { const PG8_LAS int* pml = (const PG8_LAS int*)(rsb - 16); const int sl = pml[0] == u.pm ? 0 : (pml[1] == u.pm ? 1 : (pml[2] == u.pm ? 2 : 3));
            rst = (const PG8_LAS float*)rsb + sl * 256 + wr * 64 + fr; }
#pragma unroll
        for (int ai = 0; ai < 2; ++ai)
#pragma unroll
            for (int m = 0; m < 4; ++m) {
                float esc = esc0, psc = psc0;
                if (rsb) { const float r = rst[ai * HALF + m * 16]; esc *= r; psc *= r * r; }
                const float c0 = __builtin_amdgcn_rcpf(psc);
                float v[8];
#pragma unroll
                for (int n = 0; n < 2; ++n)
#pragma unroll
                    for (int j = 0; j < 4; ++j) { const float a = acc[ai][0][m][n][j], b = acc[ai][1][m][n][j];
                        const float r = __builtin_amdgcn_rcpf(__builtin_fmaf(__builtin_amdgcn_exp2f(a * esc), c0, c0));
                        const float t = (a * b) * r;
                        v[4 * n + j] = o16 ? t : __builtin_amdgcn_fmed3f(t, -448.0f, 448.0f); }
                if (o16) { u32x4 w; w.x = cvt_pk_bf16(v[0], v[1]); w.y = cvt_pk_bf16(v[2], v[3]); w.z = cvt_pk_bf16(v[4], v[5]); w.w = cvt_pk_bf16(v[6], v[7]);
                    *(PG8_GAS u32x4*)((PG8_GAS bf16_t*)O + (size_t)(row0 + ai * HALF + m * 16) * ldc + col0) = w; continue; }
                int w0 = 0, w1 = 0;
                w0 = __builtin_amdgcn_cvt_pk_fp8_f32(v[0], v[1], w0, false); w0 = __builtin_amdgcn_cvt_pk_fp8_f32(v[2], v[3], w0, true);
                w1 = __builtin_amdgcn_cvt_pk_fp8_f32(v[4], v[5], w1, false); w1 = __builtin_amdgcn_cvt_pk_fp8_f32(v[6], v[7], w1, true);
                typedef int i32x2 __attribute__((ext_vector_type(2)));
                *(PG8_GAS i32x2*)((PG8_GAS unsigned char*)O + (size_t)(row0 + ai * HALF + m * 16) * ldc + col0) = (i32x2){w0, w1};
            }
    }
};
struct EpiRes {
    static constexpr bool PERM = false, AFTER_DRAIN = false;
    const float* base; float* out; int ldc; float scale; bf16_t* out16;
    __device__ __forceinline__ void operator()(const f32x4 (&acc)[2][2][4][2], const Unit& u, int wr, int wc, int fr, int fq) const {
        const int row0 = u.pm * BM + wr * 64 + fr, col0 = u.pnl * BM + wc * 32 + 4 * fq;
        if (ldc < 0) {
            const bool second = ldc != -DM; const int ld = DM;
            unsigned char* wsb = (unsigned char*)out - (second ? WS_HB : WS_HA);
            const float* nwc = (const float*)(wsb + WS_SMALL + SM_NWC) + (second ? DM : 0); bf16_t* an = (bf16_t*)(wsb + WS_HN); float* ssp = (float*)(wsb + WS_SMALL + SM_SS);
            const PG8_GAS float* gbase = (const PG8_GAS float*)base; PG8_GAS float* gout = (PG8_GAS float*)out; PG8_GAS bf16_t* gan = (PG8_GAS bf16_t*)an;
            PG8_GAS unsigned char* gan8 = (PG8_GAS unsigned char*)(wsb + WS_HN8); PG8_GAS float* gssp = (PG8_GAS float*)ssp; const PG8_GAS float* gnwc = (const PG8_GAS float*)nwc;
            f32x4 gw[2][2];
#pragma unroll
            for (int bj = 0; bj < 2; ++bj)
#pragma unroll
                for (int n = 0; n < 2; ++n) gw[bj][n] = second ? (f32x4){0.f, 0.f, 0.f, 0.f} : *(const PG8_GAS f32x4*)(gnwc + col0 + bj * HALF + n * 16);
            typedef unsigned u32x2_ __attribute__((ext_vector_type(2)));
            PG8_GAS bf16_t* gout16 = (PG8_GAS bf16_t*)out; const PG8_GAS bf16_t* gbase16 = (const PG8_GAS bf16_t*)base;
            f32x4 bq[2][4]; u32x2_ bh[2][4];
#define PG8_ER_LD(G, D) do { const size_t off_ = (size_t)(row0 + ((G) >> 2) * HALF + ((G) & 3) * 16) * ld + col0; _Pragma("unroll") for (int q_ = 0; q_ < 4; ++q_) D[q_] = *(const PG8_GAS f32x4*)(gbase + off_ + (q_ >> 1) * HALF + (q_ & 1) * 16); } while (0)
#define PG8_ER_LDH(G, D) do { const size_t off_ = (size_t)(row0 + ((G) >> 2) * HALF + ((G) & 3) * 16) * ld + col0; _Pragma("unroll") for (int q_ = 0; q_ < 4; ++q_) D[q_] = *(const PG8_GAS u32x2_*)(gbase16 + off_ + (q_ >> 1) * HALF + (q_ & 1) * 16); } while (0)
#define PG8_BF4(X) ((f32x4){__builtin_bit_cast(float, (X).x << 16), __builtin_bit_cast(float, (X).x & 0xffff0000u), __builtin_bit_cast(float, (X).y << 16), __builtin_bit_cast(float, (X).y & 0xffff0000u)})
            if (second) PG8_ER_LDH(0, bh[0]); else PG8_ER_LD(0, bq[0]);
#pragma unroll
            for (int g = 0; g < 8; ++g) { const int ai = g >> 2, m = g & 3;
                if (g + 1 < 8) { if (second) PG8_ER_LDH(g + 1, bh[(g + 1) & 1]); else PG8_ER_LD(g + 1, bq[(g + 1) & 1]); }
                const int row = row0 + ai * HALF + m * 16; const size_t off = (size_t)row * ld + col0; float sq = 0.f;
#pragma unroll
                for (int bj = 0; bj < 2; ++bj)
#pragma unroll
                    for (int n = 0; n < 2; ++n) { const f32x4 bv = second ? PG8_BF4(bh[g & 1][bj * 2 + n]) : bq[g & 1][bj * 2 + n];
                        const f32x4 v = acc[ai][bj][m][n] * scale + bv;
                        *(PG8_GAS u32x2_*)(gout16 + off + bj * HALF + n * 16) = (u32x2_){cvt_pk_bf16(v[0], v[1]), cvt_pk_bf16(v[2], v[3])};
                        sq += (v[0] * v[0] + v[1] * v[1]) + (v[2] * v[2] + v[3] * v[3]);
                        if (!second) { const f32x4 a = v * gw[bj][n]; int w8 = 0;       w8 = __builtin_amdgcn_cvt_pk_fp8_f32(a[0], a[1], w8, false); w8 = __builtin_amdgcn_cvt_pk_fp8_f32(a[2], a[3], w8, true);
                            *(PG8_GAS int*)(gan8 + off + bj * HALF + n * 16) = w8; } }
                sq = xrow_sum4(sq);
                if (fq == 0) gssp[(size_t)row * 32 + u.pnl * 4 + wc] = sq; }
            return;
        }
        if (u.tl() >= 0) {
            PG8_GAS float* pt = (PG8_GAS float*)out + (size_t)(u.tl() * u.ks() + u.kp()) * (BM * BM) + (size_t)(wr * 64 + fr) * BM + wc * 32 + 4 * fq;
#pragma unroll
            for (int ai = 0; ai < 2; ++ai)
#pragma unroll
                for (int m = 0; m < 4; ++m)
#pragma unroll
                    for (int bj = 0; bj < 2; ++bj)
#pragma unroll
                        for (int n = 0; n < 2; ++n) *(PG8_GAS f32x4*)(pt + (size_t)(ai * HALF + m * 16) * BM + bj * HALF + n * 16) = acc[ai][bj][m][n] * scale;
            return;
        }
        if (base && !out16) {
            typedef unsigned u32x2_ __attribute__((ext_vector_type(2)));
            const PG8_GAS bf16_t* gbase16 = (const PG8_GAS bf16_t*)base; PG8_GAS bf16_t* gout16 = (PG8_GAS bf16_t*)out; const int ld = ldc;
            u32x2_ bh[2][4];
            PG8_ER_LDH(0, bh[0]);
#pragma unroll
            for (int g = 0; g < 8; ++g) { const int ai = g >> 2, m = g & 3;
                if (g + 1 < 8) PG8_ER_LDH(g + 1, bh[(g + 1) & 1]);
                const size_t off = (size_t)(row0 + ai * HALF + m * 16) * ldc + col0;
#pragma unroll
                for (int bj = 0; bj < 2; ++bj)
#pragma unroll
                    for (int n = 0; n < 2; ++n) { const f32x4 v = acc[ai][bj][m][n] * scale + PG8_BF4(bh[g & 1][bj * 2 + n]);
                        *(PG8_GAS u32x2_*)(gout16 + off + bj * HALF + n * 16) = (u32x2_){cvt_pk_bf16(v[0], v[1]), cvt_pk_bf16(v[2], v[3])}; } }
            return;
        }
#pragma unroll
        for (int ai = 0; ai < 2; ++ai)
#pragma unroll
            for (int m = 0; m < 4; ++m) { const size_t off = (size_t)(row0 + ai * HALF + m * 16) * ldc + col0;
#pragma unroll
                for (int bj = 0; bj < 2; ++bj)
#pragma unroll
                    for (int n = 0; n < 2; ++n) { f32x4 v = acc[ai][bj][m][n] * scale;
                        if (out16) { typedef unsigned u32x2_ __attribute__((ext_vector_type(2))); *(PG8_GAS u32x2_*)((PG8_GAS bf16_t*)out16 + off + bj * HALF + n * 16) = (u32x2_){cvt_pk_bf16(v[0], v[1]), cvt_pk_bf16(v[2], v[3])}; }
                        else { if (base) v += *(const f32x4*)(base + off + bj * HALF + n * 16); *(f32x4*)(out + off + bj * HALF + n * 16) = v; } } }
    }
};

template <class Epi, class Sched, bool ALIGN_EPI = false, bool SP2 = false, bool FP8 = false>
__device__ __forceinline__ void gemm_phase(PG8_LAS unsigned char* lds, const Gemm g, const Sched& S, const Epi& E) {
    int tid_ = threadIdx.x; asm volatile("" : "+v"(tid_));
    const int tid = tid_, wid = __builtin_amdgcn_readfirstlane(tid >> 6), lane = tid & 63, wr = wid >> 2, wc = wid & 3, fr = lane & 15, fq = lane >> 4;
    const int K = g.K, nt = K / BK;
    unsigned voffA[2], voffB[2];
#pragma unroll
    for (int i = 0; i < 2; ++i) { int R, C; stage_rc(tid * 16 + i * 8192, R, C); const int Rb = Epi::PERM ? ((R & ~31) + perm32(R & 31)) : R;
        voffA[i] = (unsigned)(R * K + C) * 2u; voffB[i] = (unsigned)(Rb * K + C) * 2u; }
    const size_t kstep = (size_t)(BK * 2);
    const size_t hstep = (size_t)HALF * K * 2;
    const size_t tstep = 2 * hstep;
    const unsigned ldsw = (unsigned)wid * 1024u;
    const int aoff = lds_byte(wr * 64 + fr, fq * 8), boff = lds_byte(wc * 32 + fr, fq * 8);
#define PG8_SA(b, h) (((b) * 2 + (h)) * HTB)
#define PG8_SB(b, h) ((4 + (b) * 2 + (h)) * HTB)
#define PG8_STAGE(bufoff, gbase, voff) do { _Pragma("unroll") for (int _i = 0; _i < 2; ++_i) \
        __builtin_amdgcn_global_load_lds((const unsigned*)((const char*)(gbase) + (voff)[_i]), (PG8_LAS unsigned*)(lds + (bufoff) + ldsw + _i * 8192), 16, 0, 0); } while (0)
#define PG8_LDA(dst, b, h) do { _Pragma("unroll") for (int m = 0; m < 4; ++m) { dst[m].lo = *(const PG8_LAS bf16x8*)(lds + PG8_SA(b, h) + aoff + m * 2048); dst[m].hi = *(const PG8_LAS bf16x8*)(lds + PG8_SA(b, h) + aoff + m * 2048 + 1024); } } while (0)
#define PG8_LDB(dst, b, h) do { _Pragma("unroll") for (int n = 0; n < 2; ++n) { dst[n].lo = *(const PG8_LAS bf16x8*)(lds + PG8_SB(b, h) + boff + n * 2048); dst[n].hi = *(const PG8_LAS bf16x8*)(lds + PG8_SB(b, h) + boff + n * 2048 + 1024); } } while (0)
#define PG8_MMA(ai, bj, At, Bt) do { __builtin_amdgcn_s_setprio(1); _Pragma("unroll") for (int m = 0; m < 4; ++m) _Pragma("unroll") for (int n = 0; n < 2; ++n) { \
        if constexpr (FP8) { typedef int v8i_ __attribute__((ext_vector_type(8))); \
            asm volatile("v_mfma_scale_f32_16x16x128_f8f6f4 %0, %1, %2, %0, %3, %3 op_sel_hi:[0,0,0]" : "+v"(acc[ai][bj][m][n]) : "v"(__builtin_bit_cast(v8i_, Bt[n])), "v"(__builtin_bit_cast(v8i_, At[m])), "v"(sc1_)); } \
        else { acc[ai][bj][m][n] = __builtin_amdgcn_mfma_f32_16x16x32_bf16(Bt[n].lo, At[m].lo, acc[ai][bj][m][n], 0, 0, 0); acc[ai][bj][m][n] = __builtin_amdgcn_mfma_f32_16x16x32_bf16(Bt[n].hi, At[m].hi, acc[ai][bj][m][n], 0, 0, 0); } } \
        __builtin_amdgcn_s_setprio(0); } while (0)
#define PG8_WAIT_V(n) asm volatile("s_waitcnt vmcnt(" #n ")" ::: "memory")
#define PG8_WAIT_L(n) asm volatile("s_waitcnt lgkmcnt(" #n ")" ::: "memory")
#define PG8_BAR __builtin_amdgcn_s_barrier()
#define PG8_SCHED __builtin_amdgcn_sched_barrier(0)
    Unit cur, nxt; int ui = 0;
    if (!S.next(0, cur)) return;
    f32x4 acc[2][2][4][2];
#pragma unroll
    for (int a = 0; a < 2; ++a)
#pragma unroll
        for (int b = 0; b < 2; ++b)
#pragma unroll
            for (int m = 0; m < 4; ++m)
#pragma unroll
                for (int n = 0; n < 2; ++n) acc[a][b][m][n] = (f32x4){0.f, 0.f, 0.f, 0.f};
    typedef short s16x16 __attribute__((ext_vector_type(16)));
    s16x16 At[4], B0[2], B1[2];
    int sc1_ = 0x7f7f7f7f; asm volatile("" : "+v"(sc1_));
    const char* cA = (const char*)g.A + (size_t)cur.pm * tstep + (size_t)(cur.kp() * (nt / cur.ks())) * kstep; const char* cB = (const char*)g.Bt + (size_t)cur.pn * tstep + (size_t)(cur.kp() * (nt / cur.ks())) * kstep;
    S.a_ready(cur);
    if constexpr (SP2) {
        PG8_STAGE(PG8_SB(0, 0), cB, voffB); PG8_STAGE(PG8_SB(0, 1), cB + hstep, voffB); PG8_STAGE(PG8_SA(0, 0), cA, voffA); PG8_STAGE(PG8_SA(0, 1), cA + hstep, voffA);
        if (wr == 1) PG8_BAR;
        PG8_WAIT_V(2); PG8_BAR;
        PG8_STAGE(PG8_SB(1, 0), cB + kstep, voffB); PG8_STAGE(PG8_SA(1, 0), cA + kstep, voffA); PG8_STAGE(PG8_SB(1, 1), cB + hstep + kstep, voffB);
        PG8_WAIT_V(6); PG8_BAR;
    } else {
        PG8_STAGE(PG8_SB(0, 0), cB, voffB); PG8_STAGE(PG8_SA(0, 0), cA, voffA); PG8_STAGE(PG8_SB(0, 1), cB + hstep, voffB); PG8_STAGE(PG8_SA(0, 1), cA + hstep, voffA);
        if (wr == 1) PG8_BAR;
        PG8_WAIT_V(4); PG8_BAR;
        PG8_STAGE(PG8_SB(1, 0), cB + kstep, voffB); PG8_STAGE(PG8_SA(1, 0), cA + kstep, voffA); PG8_STAGE(PG8_SB(1, 1), cB + hstep + kstep, voffB);
        PG8_WAIT_V(6); PG8_BAR;
    }
    for (;;) {
        const bool has_next = S.next(ui + 1, nxt);
        const char* nA = has_next ? (const char*)g.A + (size_t)nxt.pm * tstep + (size_t)(nxt.kp() * (nt / nxt.ks())) * kstep : cA; const char* nB = has_next ? (const char*)g.Bt + (size_t)nxt.pn * tstep + (size_t)(nxt.kp() * (nt / nxt.ks())) * kstep : cB;
        const int ntc = nt / cur.ks();
        for (int t = 0; t < ntc; t += 2) {
            const bool last = (t == ntc - 2);
            const char* a1 = cA + (size_t)(t + 1) * kstep;
            const char* a2 = last ? nA : cA + (size_t)(t + 2) * kstep; const char* b2 = last ? nB : cB + (size_t)(t + 2) * kstep;
            const char* a3 = a2 + kstep; const char* b3 = b2 + kstep;
            if (last && has_next) S.a_ready(nxt);
            if constexpr (SP2) {
            PG8_LDB(B0, 0, 0); PG8_LDB(B1, 0, 1); PG8_SCHED; PG8_LDA(At, 0, 0); PG8_STAGE(PG8_SA(1, 1), a1 + hstep, voffA);
            PG8_WAIT_V(8); PG8_WAIT_L(0); PG8_BAR; PG8_MMA(0, 0, At, B0); PG8_MMA(0, 1, At, B1); PG8_BAR; PG8_SCHED;
            PG8_LDA(At, 0, 1); PG8_STAGE(PG8_SB(0, 0), b2, voffB); PG8_STAGE(PG8_SB(0, 1), b2 + hstep, voffB); PG8_STAGE(PG8_SA(0, 0), a2, voffA);
            PG8_WAIT_V(8); PG8_WAIT_L(0); PG8_BAR; PG8_MMA(1, 0, At, B0); PG8_MMA(1, 1, At, B1); PG8_BAR; PG8_SCHED;
            PG8_LDB(B0, 1, 0); PG8_LDB(B1, 1, 1); PG8_SCHED; PG8_LDA(At, 1, 0); PG8_STAGE(PG8_SA(0, 1), a2 + hstep, voffA);
            PG8_WAIT_V(8); PG8_WAIT_L(0); PG8_BAR; PG8_MMA(0, 0, At, B0); PG8_MMA(0, 1, At, B1); PG8_BAR; PG8_SCHED;
            PG8_LDA(At, 1, 1); PG8_STAGE(PG8_SB(1, 0), b3, voffB); PG8_STAGE(PG8_SB(1, 1), b3 + hstep, voffB); PG8_STAGE(PG8_SA(1, 0), a3, voffA);
            PG8_WAIT_V(8); PG8_WAIT_L(0); PG8_BAR; PG8_MMA(1, 0, At, B0); PG8_MMA(1, 1, At, B1); PG8_BAR; PG8_SCHED;
            } else {
            PG8_LDB(B0, 0, 0); PG8_SCHED; PG8_LDA(At, 0, 0); PG8_STAGE(PG8_SA(1, 1), a1 + hstep, voffA);
            PG8_WAIT_L(8); PG8_BAR; PG8_WAIT_L(0); PG8_MMA(0, 0, At, B0); PG8_BAR; PG8_SCHED;
            PG8_LDB(B1, 0, 1); PG8_STAGE(PG8_SB(0, 0), b2, voffB);
            PG8_BAR; PG8_WAIT_L(0); PG8_MMA(0, 1, At, B1); PG8_BAR;
            PG8_LDA(At, 0, 1); PG8_STAGE(PG8_SA(0, 0), a2, voffA);
            PG8_BAR; PG8_WAIT_L(0); PG8_MMA(1, 0, At, B0); PG8_BAR; PG8_SCHED;
            PG8_STAGE(PG8_SB(0, 1), b2 + hstep, voffB);
            PG8_WAIT_V(6); PG8_BAR; PG8_MMA(1, 1, At, B1); PG8_BAR;
            PG8_LDB(B0, 1, 0); PG8_SCHED; PG8_LDA(At, 1, 0); PG8_STAGE(PG8_SA(0, 1), a2 + hstep, voffA);
            PG8_WAIT_L(8); PG8_BAR; PG8_WAIT_L(0); PG8_MMA(0, 0, At, B0); PG8_BAR; PG8_SCHED;
            PG8_LDB(B1, 1, 1); PG8_STAGE(PG8_SB(1, 0), b3, voffB);
            PG8_BAR; PG8_WAIT_L(0); PG8_MMA(0, 1, At, B1); PG8_BAR;
            PG8_LDA(At, 1, 1); PG8_STAGE(PG8_SA(1, 0), a3, voffA);
            PG8_BAR; PG8_WAIT_L(0); PG8_MMA(1, 0, At, B0); PG8_BAR; PG8_SCHED;
            PG8_STAGE(PG8_SB(1, 1), b3 + hstep, voffB);
            PG8_WAIT_V(6); PG8_BAR; PG8_MMA(1, 1, At, B1); PG8_BAR;
            }
        }
        if constexpr (ALIGN_EPI) { if (wr == 0) PG8_BAR; }
        if constexpr (FP8) asm volatile("s_nop 15\n\ts_nop 15" ::: "memory");
        if constexpr (!Epi::AFTER_DRAIN) { E(acc, cur, wr, wc, fr, fq); S.done(cur); }
        if (!has_next) break;
#pragma unroll
        for (int a = 0; a < 2; ++a)
#pragma unroll
            for (int b = 0; b < 2; ++b)
#pragma unroll
                for (int m = 0; m < 4; ++m)
#pragma unroll
                    for (int n = 0; n < 2; ++n) acc[a][b][m][n] = (f32x4){0.f, 0.f, 0.f, 0.f};
        cur = nxt; cA = nA; cB = nB; ++ui;
        if constexpr (ALIGN_EPI) { if (wr == 1) PG8_BAR; }
    }
    PG8_WAIT_V(0);
    if constexpr (!ALIGN_EPI) { if (wr == 0) PG8_BAR; }
    PG8_BAR;
#undef PG8_SA
#undef PG8_SB
#undef PG8_STAGE
#undef PG8_LDA
#undef PG8_LDB
#undef PG8_MMA
#undef PG8_WAIT_V
#undef PG8_WAIT_L
#undef PG8_BAR
#undef PG8_SCHED
}
}


#define GAS __attribute__((address_space(1)))
#define LAS __attribute__((address_space(3)))
typedef unsigned short bf16;
typedef unsigned v4u __attribute__((ext_vector_type(4)));
typedef unsigned v2u __attribute__((ext_vector_type(2)));
typedef float f32x4 __attribute__((ext_vector_type(4)));
typedef float f32x2 __attribute__((ext_vector_type(2)));
typedef short bf16x8 __attribute__((ext_vector_type(8)));
typedef short s16x4 __attribute__((ext_vector_type(4)));
#define LDS_WAIT() asm volatile("s_waitcnt lgkmcnt(0)" ::: "memory")
__device__ __forceinline__ unsigned f2bf(float f) { unsigned u = __builtin_bit_cast(unsigned, f); return (u + 0x7fffu + ((u >> 16) & 1u)) >> 16; }
__device__ __forceinline__ unsigned pk2(float lo, float hi) { return f2bf(lo) | (f2bf(hi) << 16); }
__device__ __forceinline__ float bf2f(unsigned b) { return __builtin_bit_cast(float, b << 16); }
__device__ __forceinline__ float bflo(unsigned w) { return __builtin_bit_cast(float, w << 16); }
__device__ __forceinline__ float bfhi(unsigned w) { return __builtin_bit_cast(float, w & 0xffff0000u); }
__device__ __forceinline__ float wave_sum(float v) {
    int x = __builtin_bit_cast(int, v);
#define WS_DPP_ADD(ctrl, rmask) x = __builtin_bit_cast(int, __builtin_bit_cast(float, x) + __builtin_bit_cast(float, __builtin_amdgcn_update_dpp(0, x, (ctrl), (rmask), 0xF, false)))
    WS_DPP_ADD(0x121, 0xF); WS_DPP_ADD(0x122, 0xF); WS_DPP_ADD(0x124, 0xF); WS_DPP_ADD(0x128, 0xF);
    WS_DPP_ADD(0x142, 0xA);
    WS_DPP_ADD(0x143, 0xC);
#undef WS_DPP_ADD
    return __builtin_bit_cast(float, __builtin_amdgcn_readlane(x, 63));
}
__device__ __forceinline__ int wave_sum_i(int v) {
#pragma unroll
    for (int o = 1; o < 64; o <<= 1) v += __shfl_xor(v, o);
    return v;
}
__device__ __forceinline__ float xrow_sum(float v) {
    { const unsigned x = __builtin_bit_cast(unsigned, v); const auto r = __builtin_amdgcn_permlane32_swap(x, x, false, false); v = __builtin_bit_cast(float, (unsigned)r[0]) + __builtin_bit_cast(float, (unsigned)r[1]); }
    { const unsigned x = __builtin_bit_cast(unsigned, v); const auto r = __builtin_amdgcn_permlane16_swap(x, x, false, false); v = __builtin_bit_cast(float, (unsigned)r[0]) + __builtin_bit_cast(float, (unsigned)r[1]); }
    return v;
}
__device__ __forceinline__ float xrow_max(float v) {
    { const unsigned x = __builtin_bit_cast(unsigned, v); const auto r = __builtin_amdgcn_permlane32_swap(x, x, false, false); v = fmaxf(__builtin_bit_cast(float, (unsigned)r[0]), __builtin_bit_cast(float, (unsigned)r[1])); }
    { const unsigned x = __builtin_bit_cast(unsigned, v); const auto r = __builtin_amdgcn_permlane16_swap(x, x, false, false); v = fmaxf(__builtin_bit_cast(float, (unsigned)r[0]), __builtin_bit_cast(float, (unsigned)r[1])); }
    return v;
}
__device__ __forceinline__ float row16_sum(float v) {
    int x = __builtin_bit_cast(int, v);
#define R16_ADD(ctrl) x = __builtin_bit_cast(int, __builtin_bit_cast(float, x) + __builtin_bit_cast(float, __builtin_amdgcn_update_dpp(0, x, (ctrl), 0xF, 0xF, false)))
    R16_ADD(0x121); R16_ADD(0x122); R16_ADD(0x124); R16_ADD(0x128);
#undef R16_ADD
    return __builtin_bit_cast(float, x);
}
__device__ __forceinline__ float sigmoidf_(float x) { return __builtin_amdgcn_rcpf(1.0f + __builtin_amdgcn_exp2f(-1.4426950408889634f * x)); }
__device__ __forceinline__ float siluf_(float x) { return x * sigmoidf_(x); }
__device__ __forceinline__ float fexp(float x) { return __builtin_amdgcn_exp2f(1.4426950408889634f * x); }

#define XB_TMO      128
#define XB_XCNT(j)  (256  + 64 * (j))
#define XB_XSUB(j)  (1280 + 64 * (j))
#define XB_XGEN(j)  (2304 + 64 * (j))
#define XB_TOP      3328
#define XB_TOPGEN   3392
#define XCD_BAR_WORDS 3456
#define XB_SPIN_CAP (1u << 18)
__device__ __forceinline__ unsigned xb_ld(unsigned* p)              { return __hip_atomic_load(p, __ATOMIC_RELAXED, __HIP_MEMORY_SCOPE_AGENT); }
__device__ __forceinline__ unsigned xb_add(unsigned* p, unsigned v) { return __hip_atomic_fetch_add(p, v, __ATOMIC_RELAXED, __HIP_MEMORY_SCOPE_AGENT); }
__device__ __forceinline__ unsigned xb_xcc_id() { return (unsigned)__builtin_amdgcn_s_getreg((3 << 11) | 20) & 0xFu; }
#define XB_SPIN(cond, bar) do { unsigned _sp = 0; while (cond) { __builtin_amdgcn_s_sleep(1); \
    if ((++_sp & 255u) == 0u) { if (xb_ld(&(bar)[XB_TMO])) break; if (_sp > XB_SPIN_CAP) { atomicAdd(&(bar)[XB_TMO], 1u); break; } } } } while (0)
struct XcdBarrier { unsigned* bar; unsigned x; volatile LAS unsigned* st; };
__device__ __forceinline__ XcdBarrier xcd_barrier_post(unsigned* bar, volatile LAS unsigned* st) {
    XcdBarrier b; b.bar = bar; b.x = xb_xcc_id(); b.st = st;
    if (threadIdx.x == 0) (void)xb_add(&bar[XB_XCNT(b.x)], 1u);
    return b;
}
__device__ __forceinline__ void xcd_barrier_complete(unsigned* bar, unsigned x, unsigned& nloc, unsigned& nx) {
    const unsigned G = gridDim.x * gridDim.y * gridDim.z;
    unsigned sum, cnt, mine, sp = 0u;
    for (;;) {
        sum = 0u; cnt = 0u; mine = 0u;
#pragma unroll
        for (unsigned j = 0; j < 16; ++j) { const unsigned c = xb_ld(&bar[XB_XCNT(j)]); sum += c; cnt += (c > 0u) ? 1u : 0u; mine = (j == x) ? c : mine; }
        if (sum == G) break;
        __builtin_amdgcn_s_sleep(1);
        if ((++sp & 255u) == 0u) { if (xb_ld(&bar[XB_TMO])) break; if (sp > XB_SPIN_CAP) { atomicAdd(&bar[XB_TMO], 1u); break; } }
    }
    nloc = mine > 0u ? mine : 1u; nx = cnt > 0u ? cnt : 1u;
}
__device__ __forceinline__ void xcd_barrier(const XcdBarrier& b) {
    asm volatile("s_waitcnt vmcnt(0)" ::: "memory");
    __syncthreads();
    if (threadIdx.x == 0) {
        unsigned* bar = b.bar;
        __builtin_amdgcn_s_waitcnt(0);
        unsigned nloc = b.st[0], nx = b.st[1];
        if (nloc == 0u) { xcd_barrier_complete(bar, b.x, nloc, nx); b.st[0] = nloc; b.st[1] = nx; }
        const unsigned old = xb_add(&bar[XB_XSUB(b.x)], 1u);
        const unsigned gen = old / nloc;
        if (old + 1u == (gen + 1u) * nloc) {
            __builtin_amdgcn_fence(__ATOMIC_RELEASE, "agent");
            asm volatile("s_waitcnt vmcnt(0)" ::: "memory");
            const unsigned og = xb_add(&bar[XB_TOP], 1u);
            const unsigned tg = og / nx;
            if (og + 1u == (tg + 1u) * nx) xb_add(&bar[XB_TOPGEN], 1u);
            else XB_SPIN(xb_ld(&bar[XB_TOPGEN]) == tg, bar);
            __builtin_amdgcn_fence(__ATOMIC_ACQUIRE, "agent");
            xb_add(&bar[XB_XGEN(b.x)], 1u);
            asm volatile("s_waitcnt vmcnt(0)" ::: "memory");
        } else {
            XB_SPIN(xb_ld(&bar[XB_XGEN(b.x)]) == gen, bar);
            __builtin_amdgcn_fence(__ATOMIC_ACQUIRE, "agent");
            asm volatile("s_waitcnt vmcnt(0)" ::: "memory");
        }
    }
    __syncthreads();
}

static __device__ __noinline__ void grid_barrier(LAS unsigned char* lds) {
    volatile LAS unsigned* MISC = (volatile LAS unsigned*)(lds + 131072);
    volatile LAS unsigned* ap = (volatile LAS unsigned*)(lds + 131072 + 1024) + 2 * 24; unsigned lo = ap[0], hi = ap[1];
    lo = __builtin_amdgcn_readfirstlane(lo); hi = __builtin_amdgcn_readfirstlane(hi);
    XcdBarrier b; b.bar = (unsigned*)(((unsigned long long)hi << 32) | lo) + 4096; b.x = __builtin_amdgcn_readfirstlane(MISC[2]); b.st = MISC;
    xcd_barrier(b);
}
template <int K>
__device__ __forceinline__ f32x4 mma_lds(f32x4 acc, const LAS unsigned char* A, int pa, const LAS unsigned char* Bt, int pb, int lane) {
    const int i = lane & 15, g = lane >> 4;
#pragma unroll
    for (int k = 0; k < K; k += 32) {
        const bf16x8 a = *(const LAS bf16x8*)(A + i * pa + (k + 8 * g) * 2);
        const bf16x8 b = *(const LAS bf16x8*)(Bt + i * pb + (k + 8 * g) * 2);
        acc = __builtin_amdgcn_mfma_f32_16x16x32_bf16(a, b, acc, 0, 0, 0);
    }
    return acc;
}

struct Args { const float* in[23]; float* out; unsigned char* ws; int ph_lo, ph_hi; };
enum { I_X = 0, I_NMIX, I_WIN, I_SCW, I_SCB, I_SDTB, I_SALOG, I_SD, I_SNW, I_CCW, I_CCB, I_CLW, I_CLB, I_WOUT, I_NFFN, I_FG, I_FU, I_FD, I_RT, I_MG, I_MU, I_MD, I_NFIN };

constexpr int ARGS_OFF = 131072 + 1024;
__device__ __forceinline__ const void* ldarg(LAS unsigned char* lds, int k) {
    volatile LAS unsigned* p = (volatile LAS unsigned*)(lds + ARGS_OFF) + 2 * k; unsigned lo = p[0], hi = p[1];
    lo = __builtin_amdgcn_readfirstlane(lo); hi = __builtin_amdgcn_readfirstlane(hi); return (const void*)(((unsigned long long)hi << 32) | lo); }
__device__ __forceinline__ const void* ldarg_g(LAS unsigned char* lds, int k) {
    volatile LAS unsigned* p = (volatile LAS unsigned*)(lds + ARGS_OFF) + 2 * k; unsigned lo = p[0], hi = p[1];
    lo = __builtin_amdgcn_readfirstlane(lo); hi = __builtin_amdgcn_readfirstlane(hi);
    const GAS char* gp = (const GAS char*)(((unsigned long long)hi << 32) | lo); return (const void*)gp; }
#define ARGWS_G() ((unsigned char*)ldarg_g(lds, 24))
#define ARGF_G(k) ((const float*)ldarg_g(lds, (k)))
#define ARGF(k) ((const float*)ldarg(lds, (k)))
#define ARGWS() ((unsigned char*)ldarg(lds, 24))
#define ARGOUT() ((float*)ldarg(lds, 23))
struct CvDesc { const float* src; unsigned char* dst; unsigned ld, pitchB; int f8; const float* gk; };
__device__ __forceinline__ void cv_load(const CvDesc& d, f32x4 (&v)[16], int lane) {
    const int kr = lane >> 4, c4 = lane & 15;
#pragma unroll
    for (int i = 0; i < 16; ++i) v[i] = __builtin_nontemporal_load((const f32x4*)(d.src + (size_t)(4 * i + kr) * d.ld + 4 * c4));
}
__device__ __forceinline__ void cv_store(const CvDesc& d, const f32x4 (&v)[16], LAS unsigned char* scr, int lane) {
    const int kr = lane >> 4, c4 = lane & 15;
    const float wsc = d.f8 ? 128.0f : 1.0f;
    if (d.gk) {
        float gr[16];
#pragma unroll
        for (int i = 0; i < 16; ++i) gr[i] = d.gk[4 * i + kr];
#pragma unroll
        for (int i = 0; i < 16; ++i) { const float ws2 = wsc * gr[i]; v2u w; w.x = pg8::cvt_pk_bf16(v[i][0] * ws2, v[i][1] * ws2); w.y = pg8::cvt_pk_bf16(v[i][2] * ws2, v[i][3] * ws2); *(LAS v2u*)(scr + (4 * i + kr) * 136 + 8 * c4) = w; }
    } else {
#pragma unroll
    for (int i = 0; i < 16; ++i) { v2u w; w.x = pg8::cvt_pk_bf16(v[i][0] * wsc, v[i][1] * wsc); w.y = pg8::cvt_pk_bf16(v[i][2] * wsc, v[i][3] * wsc); *(LAS v2u*)(scr + (4 * i + kr) * 136 + 8 * c4) = w; }
    }
    LDS_WAIT(); asm volatile("" ::: "memory");
    const int g = lane >> 4, i16 = lane & 15, q = i16 >> 2, p = i16 & 3;
    if (d.f8) {
#pragma unroll
        for (int j = 0; j < 4; ++j) {
            const int nb = 16 * j;
            int w[4];
#pragma unroll
            for (int r = 0; r < 4; ++r) {
                const s16x4 a = __builtin_amdgcn_ds_read_tr16_b64_v4i16((LAS s16x4*)(scr + (16 * g + 4 * r + q) * 136 + (nb + 4 * p) * 2));
                int t = 0; t = __builtin_amdgcn_cvt_pk_fp8_f32(bf2f((unsigned short)a[0]), bf2f((unsigned short)a[1]), t, false); t = __builtin_amdgcn_cvt_pk_fp8_f32(bf2f((unsigned short)a[2]), bf2f((unsigned short)a[3]), t, true);
                w[r] = t;
            }
            typedef int i32x4 __attribute__((ext_vector_type(4)));
            __builtin_nontemporal_store((i32x4){w[0], w[1], w[2], w[3]}, (i32x4*)(d.dst + (size_t)(nb + i16) * d.pitchB + 16 * g));
        }
        LDS_WAIT(); asm volatile("" ::: "memory");
        return;
    }
#pragma unroll
    for (int j = 0; j < 8; ++j) {
        const int nb = 16 * (j & 3), kc = (j >> 2) * 4 + g;
        const LAS unsigned char* ad = scr + (8 * kc + q) * 136 + (nb + 4 * p) * 2;
        const s16x4 a0 = __builtin_amdgcn_ds_read_tr16_b64_v4i16((LAS s16x4*)ad);
        const s16x4 a1 = __builtin_amdgcn_ds_read_tr16_b64_v4i16((LAS s16x4*)(ad + 4 * 136));
        unsigned char* rowp = d.dst + (size_t)(nb + i16) * d.pitchB;
        { const bf16x8 o = {a0[0], a0[1], a0[2], a0[3], a1[0], a1[1], a1[2], a1[3]};
            *(bf16x8*)(rowp + 16 * kc) = o; }
    }
    LDS_WAIT(); asm volatile("" ::: "memory");
}
constexpr int IT_IN = 32 * (NP / 64), IT_OUT = 32 * 32, IT_GU = 32 * 224, IT_DN = 112 * 32, IT_FF = IT_GU + IT_DN;
constexpr int IT_EARLY = 2 * IT_IN + 2 * IT_OUT + IT_FF;
constexpr int IT_TOTAL = IT_EARLY + 8 * IT_FF;
__device__ __forceinline__ CvDesc cv_decode(LAS unsigned char* lds, int it) {
    unsigned char* ws = ARGWS_G(); CvDesc d; d.gk = nullptr; int r = it;
    if (r < 2 * IT_IN) {
        const int l = r / IT_IN; r -= l * IT_IN; const int kb = r / (NP / 64), gi = r % (NP / 64), phys = 64 * gi; int scol;
        if (phys < 2048) { const int part = phys >> 10, within = phys & 1023, pn = within >> 8, bj = (within >> 7) & 1, o = within & 127; scol = part * 1024 + (2 * pn + (o >> 6)) * 128 + 64 * bj + (o & 63); }
        else if (phys < 4608) scol = phys; else scol = phys + 8;
        d.src = ARGF_G(I_WIN) + (size_t)l * DM * IN_DIM + (size_t)(64 * kb) * IN_DIM + scol; d.ld = IN_DIM; d.pitchB = DM * 2; d.f8 = 0;
        d.dst = ws + WS_WIN + ((size_t)l * NP * DM + (size_t)phys * DM + 64 * kb) * 2;
        if (l == 1) d.gk = ARGF_G(I_NMIX) + DM + 64 * kb;
        return d;
    }
    r -= 2 * IT_IN;
    if (r < 2 * IT_OUT) {
        const int l = r / IT_OUT; r -= l * IT_OUT; const int kb = r / 32, gi = r % 32;
        d.src = ARGF_G(I_WOUT) + (size_t)l * DM * DM + (size_t)(64 * kb) * DM + 64 * gi; d.ld = DM; d.pitchB = DM * 2; d.f8 = 0;
        d.dst = ws + WS_WOUT + ((size_t)l * DM * DM + (size_t)(64 * gi) * DM + 64 * kb) * 2; return d;
    }
    r -= 2 * IT_OUT;
    const int e9 = r / IT_FF; r -= e9 * IT_FF;
    if (r < IT_GU) {
        int kb = r / 224, gi = r % 224; if (e9) { kb = 2 * (r / 448) + (r & 1); gi = (r % 448) >> 1; }
        const int phys = 64 * gi, pn = phys >> 8, bj = (phys >> 7) & 1, o = phys & 127, ff = 128 * pn + o;
        const float* src = e9 == 0 ? ARGF_G(bj ? I_FU : I_FG) : (ARGF_G(bj ? I_MU : I_MG) + (size_t)(e9 - 1) * DM * DFF);
        d.src = src + (size_t)(64 * kb) * DFF + ff; d.ld = DFF;
        if (e9 == 0) { d.f8 = 1; d.pitchB = DM; d.dst = ws + WS_WGU + (size_t)phys * DM + 64 * kb; }
        else { d.f8 = 1; d.pitchB = DM; d.dst = ws + WS_WGU8 + (size_t)(e9 - 1) * 2 * DFF * DM + (size_t)phys * DM + 64 * kb; }
    } else {
        r -= IT_GU; int kb = r / 32, gi = r % 32; if (e9) { kb = 2 * (r / 64) + (r & 1); gi = (r % 64) >> 1; }
        const float* src = e9 == 0 ? ARGF_G(I_FD) : (ARGF_G(I_MD) + (size_t)(e9 - 1) * DFF * DM);
        d.src = src + (size_t)(64 * kb) * DM + 64 * gi; d.ld = DM;
        if (e9 == 0) { d.f8 = 0; d.pitchB = DFF * 2; d.dst = ws + WS_WDN + ((size_t)(64 * gi) * DFF + 64 * kb) * 2; }
        else { d.f8 = 1; d.pitchB = DFF; d.dst = ws + WS_WDN8 + (size_t)(e9 - 1) * DM * DFF + (size_t)(64 * gi) * DFF + 64 * kb; }
    }
    return d;
}
__device__ __forceinline__ void cv_run(LAS unsigned char* lds, LAS unsigned char* scr, int lane, int it0, int stride, int it_end) {
    asm volatile("" : "+v"(lane));
#pragma unroll 1
    for (int it = it0; it < it_end; it += stride) {
        const CvDesc da = cv_decode(lds, it); f32x4 va[16];
        cv_load(da, va, lane);
        cv_store(da, va, scr, lane);
    }
}
__device__ __forceinline__ void p0_prologue(LAS unsigned char* lds, int tid, int lane, int wave, int vcu, int G) {
    LAS unsigned char* scr = lds + wave * 16384;
    const int gw = vcu * NWAVES + wave, NGW = G * NWAVES;
    unsigned char* ws = ARGWS();
    cv_run(lds, scr, lane, gw, NGW, IT_IN);
    if (vcu == 0) { const float* nf = ARGF(I_NFFN); const float* nm = ARGF(I_NMIX) + DM; float* nwc = (float*)(ws + WS_SMALL + SM_NWC);
        for (int k = tid; k < DM; k += 512) { nwc[k] = nf[k]; nwc[DM + k] = nm[k]; } if (tid < 8) nwc[2 * DM + tid] = ARGF(I_SDTB)[8 + tid]; }
    if (vcu == 1 % G) {
        bf16* dtt = (bf16*)(ws + WS_WIN) + (size_t)2 * NP * DM; const float* wi = ARGF(I_WIN) + (size_t)DM * IN_DIM + 4608;
        for (int k = tid; k < DM; k += 512) { const float gk_ = ARGF(I_NMIX)[DM + k];
            const f32x4 a = *(const f32x4*)(wi + (size_t)k * IN_DIM) * gk_, b = *(const f32x4*)(wi + (size_t)k * IN_DIM + 4) * gk_;
            dtt[0 * DM + k] = (bf16)f2bf(a[0]); dtt[1 * DM + k] = (bf16)f2bf(a[1]); dtt[2 * DM + k] = (bf16)f2bf(a[2]); dtt[3 * DM + k] = (bf16)f2bf(a[3]);
            dtt[4 * DM + k] = (bf16)f2bf(b[0]); dtt[5 * DM + k] = (bf16)f2bf(b[1]); dtt[6 * DM + k] = (bf16)f2bf(b[2]); dtt[7 * DM + k] = (bf16)f2bf(b[3]); }
        v4u* z = (v4u*)(dtt + 8 * DM); const v4u zero = {0u, 0u, 0u, 0u};
        for (int q = tid; q < 248 * DM * 2 / 16; q += 512) z[q] = zero;
    }
    float* rope = (float*)(ws + WS_ROPE);
    for (int idx = (vcu * NWAVES + wave) * 64 + lane; idx < SEQ * 64; idx += NGW * 64) {
        const int pos = idx >> 6, i = idx & 63;
        const float inv = __builtin_amdgcn_exp2f(-(float)(2 * i) * (13.287712379549449f / 128.0f));
        const float ang = (float)pos * inv;
        const float t = ang * 0.15915494309189535f, fr = t - floorf(t);
        rope[2 * idx] = __builtin_amdgcn_cosf(fr); rope[2 * idx + 1] = __builtin_amdgcn_sinf(fr);
    }
}

template <int MODE>
static __device__ __noinline__ void norm_phase(LAS unsigned char* lds, int tid, int lane, int wave, int vcu, int G,
        const float* __restrict__ hin, const float* __restrict__ nw, bf16* __restrict__ hn, const float* __restrict__ wsm, size_t ldsm,
        const float* __restrict__ bias8, float* __restrict__ dt_out, int* __restrict__ tok_e, f32x2* __restrict__ tok_g, int* __restrict__ wcnt, int* __restrict__ bcnt) {
    const GAS float* hin_g = (const GAS float*)hin; const GAS float* nw_g = (const GAS float*)nw; GAS unsigned char* hn_g = (GAS unsigned char*)hn;
    GAS float* dt_g = (GAS float*)dt_out; GAS int* toke_g = (GAS int*)tok_e; GAS f32x2* tokg_g = (GAS f32x2*)tok_g;
    LAS f32x4* wlA = (LAS f32x4*)lds;
    LAS f32x4* wlB = (LAS f32x4*)(lds + 32768);
    LAS int* lcnt = (LAS int*)(lds + 65536);
    if (MODE != 2) for (int k = tid; k < DM; k += 512) { const f32x4 va = *(const f32x4*)(wsm + (size_t)k * ldsm), vb = *(const f32x4*)(wsm + (size_t)k * ldsm + 4);
        const int j = k >> 8, ln = (k & 255) >> 2, e = k & 3, slot = (j * 4 + e) * 64 + ln; wlA[slot] = va; wlB[slot] = vb; }
    if (MODE == 1 && tid < 8) lcnt[tid] = 0;
    LAS f32x4* wlG = (LAS f32x4*)(lds + 65536 + 256);
    wlG[tid] = *(const GAS f32x4*)(nw_g + 4 * tid);
    __syncthreads();
    const int NGW = G * NWAVES, gw = vcu * NWAVES + wave, RPW = (M + NGW - 1) / NGW;
    int mycnt = 0;
    f32x4 xn[8]; v2u xh[8];
    const GAS bf16* hin16 = (const GAS bf16*)hin_g;
    { const int r0 = min(gw * RPW, M - 1);
#pragma unroll
      for (int j = 0; j < 8; ++j) { if (MODE == 1) xh[j] = *(const GAS v2u*)(hin16 + (size_t)r0 * DM + 4 * lane + 256 * j); else xn[j] = *(const GAS f32x4*)(hin_g + (size_t)r0 * DM + 4 * lane + 256 * j); } }
    for (int i = 0; i < RPW; ++i) {
        const int row = gw * RPW + i; if (row >= M) break;
        f32x4 x[8]; float ss = 0.f;
#pragma unroll
        for (int j = 0; j < 8; ++j) { x[j] = MODE == 1 ? (f32x4){bflo(xh[j].x), bfhi(xh[j].x), bflo(xh[j].y), bfhi(xh[j].y)} : xn[j]; ss += (x[j][0] * x[j][0] + x[j][1] * x[j][1]) + (x[j][2] * x[j][2] + x[j][3] * x[j][3]); }
        { const int rn = min(row + 1, M - 1);
#pragma unroll
          for (int j = 0; j < 8; ++j) { if (MODE == 1) xh[j] = *(const GAS v2u*)(hin16 + (size_t)rn * DM + 4 * lane + 256 * j); else xn[j] = *(const GAS f32x4*)(hin_g + (size_t)rn * DM + 4 * lane + 256 * j); } }
        ss = wave_sum(ss);
        const float rstd = 1.0f / sqrtf(ss * (1.0f / DM) + EPS);
        f32x4 accA = {0.f, 0.f, 0.f, 0.f}, accB = {0.f, 0.f, 0.f, 0.f};
#pragma unroll
        for (int j = 0; j < 8; ++j) {
            const f32x4 y = x[j] * rstd * wlG[j * 64 + lane];
            if (MODE == 1) { int w8 = 0; w8 = __builtin_amdgcn_cvt_pk_fp8_f32(y[0], y[1], w8, false); w8 = __builtin_amdgcn_cvt_pk_fp8_f32(y[2], y[3], w8, true);
                *(GAS int*)(hn_g + (size_t)row * DM + 4 * lane + 256 * j) = w8; }
            else { v2u o; o.x = pk2(y[0], y[1]); o.y = pk2(y[2], y[3]);
            *(GAS v2u*)(hn_g + ((size_t)row * DM + 4 * lane + 256 * j) * 2) = o; }
            if (MODE != 2) {
#pragma unroll
            for (int e = 0; e < 4; ++e) { const f32x4 wa = wlA[(j * 4 + e) * 64 + lane], wb = wlB[(j * 4 + e) * 64 + lane]; accA += y[e] * wa; accB += y[e] * wb; }
            }
        }
        if (MODE == 2) continue;
        float acc[8];
#pragma unroll
        for (int c = 0; c < 4; ++c) { acc[c] = wave_sum(accA[c]); acc[4 + c] = wave_sum(accB[c]); }
        if (MODE == 0) {
            float v = acc[0];
#pragma unroll
            for (int c = 1; c < 8; ++c) v = (lane == c) ? acc[c] : v;
            if (lane < 8) { const float xx = v + bias8[lane]; dt_g[(size_t)row * 8 + lane] = fmaxf(xx, 0.f) + log1pf(expf(-fabsf(xx))); }
        } else {
            float v0 = acc[0]; int i0 = 0;
#pragma unroll
            for (int c = 1; c < 8; ++c) if (acc[c] > v0) { v0 = acc[c]; i0 = c; }
            float v1 = -INFINITY; int i1 = 0;
#pragma unroll
            for (int c = 0; c < 8; ++c) if (c != i0 && acc[c] > v1) { v1 = acc[c]; i1 = c; }
            const float ex = expf(v1 - v0), g0 = 1.0f / (1.0f + ex), g1 = ex * g0;
            if (lane == 0) { toke_g[row] = i0 | (i1 << 8); tokg_g[row] = (f32x2){g0, g1}; }
            if (lane == i0 || lane == i1) ++mycnt;
        }
    }
    if (MODE == 1) {
        if (lane < 8) { wcnt[gw * 8 + lane] = mycnt; __hip_atomic_fetch_add(lcnt + lane, mycnt, __ATOMIC_RELAXED, __HIP_MEMORY_SCOPE_WORKGROUP); }
        __syncthreads();
        if (tid < 8) bcnt[vcu * 8 + tid] = lcnt[tid];
    }
    __syncthreads();
}

static __device__ __noinline__ void gather_phase(LAS unsigned char* lds, int tid, int lane, int wave, int vcu, int G) {
    unsigned char* ws = ARGWS_G();
    LAS int* tt = (LAS int*)lds;
    const int* bcnt = (const int*)(ws + WS_SMALL + SM_BCNT); const int* wcnt = (const int*)(ws + WS_SMALL + SM_WCNT);
    const int* tok_e = (const int*)(ws + WS_SMALL + SM_TOKE); int* pos = (int*)(ws + WS_SMALL + SM_POS);
    const unsigned char* hn = ws + WS_HN8; unsigned char* xp = ws + WS_XP8;
    { int st = 0, sp = 0; for (int b2 = lane; b2 < G; b2 += 64) { const int v = bcnt[b2 * 8 + wave]; st += v; if (b2 < vcu) sp += v; }
      st = wave_sum_i(st); sp = wave_sum_i(sp); if (lane == 0) { tt[wave] = st; tt[8 + wave] = sp; } }
    __syncthreads();
    int run = 0;
    if (lane < 8) { int base = 0;
#pragma unroll
        for (int e2 = 0; e2 < 8; ++e2) if (e2 < lane) base += ((tt[e2] + 255) >> 8) << 8;
        run = base + tt[8 + lane];
        for (int w2 = 0; w2 < wave; ++w2) run += wcnt[(vcu * NWAVES + w2) * 8 + lane]; }
    if (vcu == 0 && tid < 8) ((int*)(ws + WS_SMALL + SM_ETOT))[tid] = tt[tid];
    const int NGW = G * NWAVES, gw = vcu * NWAVES + wave, RPW = (M + NGW - 1) / NGW;
    for (int ib = 0; ib < RPW; ib += 4) {
        int te4[4]; v4u v4[4][2];
#pragma unroll
        for (int k = 0; k < 4; ++k) { const int rc = min(gw * RPW + ib + k, M - 1); te4[k] = tok_e[rc]; const v4u* s = (const v4u*)(hn + (size_t)rc * DM) + lane; v4[k][0] = s[0]; v4[k][1] = s[64]; }
#pragma unroll
        for (int k = 0; k < 4; ++k) {
            const int row = gw * RPW + ib + k; if (ib + k >= RPW || row >= M) break;
            const int i0 = te4[k] & 0xff, i1 = te4[k] >> 8;
            const int p0 = __shfl(run, i0); if (lane == i0) ++run;
            const int p1 = __shfl(run, i1); if (lane == i1) ++run;
            if (lane == 0) { pos[2 * row] = p0; pos[2 * row + 1] = p1; }
            v4u* d0 = (v4u*)(xp + (size_t)p0 * DM) + lane; v4u* d1 = (v4u*)(xp + (size_t)p1 * DM) + lane;
            d0[0] = v4[k][0]; d1[0] = v4[k][0]; d0[64] = v4[k][1]; d1[64] = v4[k][1];
        }
    }
    __syncthreads();
}

static __device__ __noinline__ void combine_phase(LAS unsigned char* lds, int lane, int wave, int vcu, int G) {
    unsigned char* ws = ARGWS_G(); const float* nw = ARGF_G(I_NFIN); float* out = ARGOUT();
    const float* hA = (const float*)(ws + WS_HA); const bf16* Y = (const bf16*)(ws + WS_Y); const float* YT = (const float*)(ws + WS_YT);
    const int* pos = (const int*)(ws + WS_SMALL + SM_POS); const f32x2* tok_g = (const f32x2*)(ws + WS_SMALL + SM_TOKG); const int* tok_e = (const int*)(ws + WS_SMALL + SM_TOKE);
    const LAS int* stb = (const LAS int*)(lds + SCHED_OFF);
    const int nfull = stb[80], S = stb[81];
    const int NGW = G * NWAVES, gw = vcu * NWAVES + wave;
    int p0n, p1n, ten; f32x2 ggn;
    { const int rc = min(gw, M - 1); p0n = pos[2 * rc]; p1n = pos[2 * rc + 1]; ggn = tok_g[rc]; ten = tok_e[rc]; }
    for (int row = gw; row < M; row += NGW) {
        const int p0 = p0n, p1 = p1n; const f32x2 gg = ggn;
        const int te = ten, e0 = te & 0xff, e1 = te >> 8;
        { const int rc = min(row + NGW, M - 1); p0n = pos[2 * rc]; p1n = pos[2 * rc + 1]; ggn = tok_g[rc]; ten = tok_e[rc]; }
        const int w0b = stb[48 + e0] + (p0 >> 8) - stb[40 + e0], m0 = stb[32 + e0], w1b = stb[48 + e1] + (p1 >> 8) - stb[40 + e1], m1 = stb[32 + e1];
        f32x4 x[8]; v2u ya[8], yb[8]; float ss = 0.f;
#pragma unroll
        for (int j = 0; j < 8; ++j) { const int o = 4 * lane + 256 * j;
            ya[j] = *(const v2u*)(Y + (size_t)p0 * DM + o); yb[j] = *(const v2u*)(Y + (size_t)p1 * DM + o);
            { const v2u t = *(const v2u*)((const bf16*)hA + (size_t)row * DM + o); x[j] = (f32x4){bflo(t.x), bfhi(t.x), bflo(t.y), bfhi(t.y)}; } }
#pragma unroll
        for (int j = 0; j < 8; ++j) {
            f32x4 y0 = (f32x4){bflo(ya[j].x), bfhi(ya[j].x), bflo(ya[j].y), bfhi(ya[j].y)}, y1 = (f32x4){bflo(yb[j].x), bfhi(yb[j].x), bflo(yb[j].y), bfhi(yb[j].y)};
            const int w0 = w0b + j * m0, w1 = w1b + j * m1;
            if (w0 >= nfull) { y0 = (f32x4){0.f, 0.f, 0.f, 0.f}; for (int kp = 0; kp < S; ++kp) y0 += *(const f32x4*)(YT + ((size_t)((w0 - nfull) * S + kp) * 256 + (p0 & 255)) * 256 + 4 * lane); }
            if (w1 >= nfull) { y1 = (f32x4){0.f, 0.f, 0.f, 0.f}; for (int kp = 0; kp < S; ++kp) y1 += *(const f32x4*)(YT + ((size_t)((w1 - nfull) * S + kp) * 256 + (p1 & 255)) * 256 + 4 * lane); }
            x[j] += gg[0] * y0 + gg[1] * y1;
            ss += (x[j][0] * x[j][0] + x[j][1] * x[j][1]) + (x[j][2] * x[j][2] + x[j][3] * x[j][3]); }
        ss = wave_sum(ss);
        const float rstd = 1.0f / sqrtf(ss * (1.0f / DM) + EPS);
#pragma unroll
        for (int j = 0; j < 8; ++j) { const int o = 4 * lane + 256 * j; *(f32x4*)(out + (size_t)row * DM + o) = x[j] * rstd * *(const f32x4*)(nw + o); }
    }
}

static __device__ __noinline__ void kmean_unit(LAS unsigned char* lds, int tid, int u, const bf16* __restrict__ P, float* __restrict__ kmean) {
    const int h = u & 7, blk = (u >> 3) % 7, b = u / 56;
    const bf16* Kp = P + (size_t)(b * SEQ + blk * 256) * NP + PC_K + h * 128;
    const int c = tid & 15, rg = tid >> 4;
    float s[8];
#pragma unroll
    for (int e = 0; e < 8; ++e) s[e] = 0.f;
#pragma unroll
    for (int r = 0; r < 8; ++r) { const v4u v = *(const v4u*)(Kp + (size_t)(rg * 8 + r) * NP + c * 8);
        s[0] += bflo(v.x); s[1] += bfhi(v.x); s[2] += bflo(v.y); s[3] += bfhi(v.y); s[4] += bflo(v.z); s[5] += bfhi(v.z); s[6] += bflo(v.w); s[7] += bfhi(v.w); }
    LAS float* red = (LAS float*)lds;
#pragma unroll
    for (int e = 0; e < 8; ++e) red[rg * 128 + c * 8 + e] = s[e];
    __syncthreads();
    if (tid < 128) { float t = 0.f;
#pragma unroll 8
        for (int r = 0; r < 32; ++r) t += red[r * 128 + tid];
        kmean[(size_t)((b * 8 + h) * 8 + blk) * 128 + tid] = t * (1.0f / 256.0f); }
    __syncthreads();
}

template <int NT>
__device__ __forceinline__ void conv_load(const bf16* __restrict__ Pc, int t0, int seqpos0, const float* __restrict__ cw, const float* __restrict__ cb, unsigned (&raw)[NT + 3], f32x2 (&w)[4], f32x2& bb) {
#pragma unroll
    for (int j = 0; j < 4; ++j) w[j] = *(const f32x2*)(cw + j * 1024);
    bb = *(const f32x2*)cb;
#pragma unroll
    for (int i = 0; i < NT + 3; ++i) { const int t = t0 - 3 + i; const bool ok = seqpos0 + t >= 0; const unsigned v = *(const unsigned*)(Pc + (ptrdiff_t)(ok ? t : -seqpos0) * NP); raw[i] = ok ? v : 0u; }
}
template <int NT>
__device__ __forceinline__ void conv_apply(const unsigned (&raw)[NT + 3], const f32x2 (&w)[4], const f32x2 bb, float (&o0)[NT], float (&o1)[NT]) {
#pragma unroll
    for (int i = 0; i < NT; ++i) { float a0 = bb[0], a1 = bb[1];
#pragma unroll
        for (int j = 0; j < 4; ++j) { a0 += w[j][0] * bflo(raw[i + j]); a1 += w[j][1] * bfhi(raw[i + j]); }
        o0[i] = siluf_(a0); o1[i] = siluf_(a1); }
}

static __device__ __noinline__ void ssd1_unit(LAS unsigned char* lds, int tid, int lane, int wave, int u, int layer) {
    unsigned char* ws = ARGWS_G(); const float* scw = ARGF_G(I_SCW) + (size_t)layer * 4096; const float* scb = ARGF_G(I_SCB) + layer * 1024;
    const int h = u & 7, c = (u >> 3) & 15, b = u >> 7, g = h >> 2;
    const int row0 = b * SEQ + c * 128;
    const bf16* P = (const bf16*)(ws + WS_P); float* XC = (float*)(ws + WS_XC);
    const float* DT = (const float*)(ws + WS_SMALL + SM_DT); float* LAC = (float*)(ws + WS_SMALL + SM_LAC); float* DEC = (float*)(ws + WS_SMALL + SM_DEC); float* ST = (float*)(ws + WS_ST);
    LAS float* wgl = (LAS float*)lds;
    LAS unsigned char* xT = lds + 2048;
    LAS unsigned char* BT = xT + 17408;
    const bool doC = (h & 3) == 1;
    const int cpx = tid & 31, runx = tid >> 5, chx = h * 64 + 2 * cpx, t0x = runx * 8;
    const int cpb = tid & 63, runb = tid >> 6, chb = 512 + g * 128 + 2 * cpb, t0b = runb * 16;
    const int chc = 768 + g * 128 + 2 * cpb;
    unsigned rx[11], rb[19], rc[19]; f32x2 wx[4], wb[4], wc4[4]; f32x2 bx2, bb2, bc2;
    conv_load<8>(P + (size_t)row0 * NP + PC_X + chx, t0x, c * 128, scw + chx, scb + chx, rx, wx, bx2);
    conv_load<16>(P + (size_t)row0 * NP + PC_X + chb, t0b, c * 128, scw + chb, scb + chb, rb, wb, bb2);
    if (doC) conv_load<16>(P + (size_t)row0 * NP + PC_X + chc, t0b, c * 128, scw + chc, scb + chc, rc, wc4, bc2);
    if (wave == 0) {
        const float a = -expf(ARGF_G(I_SALOG)[layer * 8 + h]);
        const float d0 = DT[(size_t)(row0 + 2 * lane) * 8 + h], d1 = DT[(size_t)(row0 + 2 * lane + 1) * 8 + h];
        const float l0 = d0 * a, l1 = d1 * a;
        float sc = l0 + l1;
#pragma unroll
        for (int o = 1; o < 64; o <<= 1) { const float t = __shfl_up(sc, o); if (lane >= o) sc += t; }
        const float c1 = sc, c0 = sc - l1, tot = __shfl(sc, 63);
        wgl[2 * lane] = d0 * expf(tot - c0); wgl[2 * lane + 1] = d1 * expf(tot - c1);
        LAC[(size_t)(row0 + 2 * lane) * 8 + h] = c0; LAC[(size_t)(row0 + 2 * lane + 1) * 8 + h] = c1;
        if (lane == 0) DEC[(b * 16 + c) * 8 + h] = expf(tot);
    }
    __syncthreads();
    {
        float o0[8], o1[8];
        conv_apply<8>(rx, wx, bx2, o0, o1);
#pragma unroll
        for (int i = 0; i < 8; ++i) { const int t = t0x + i; *(unsigned*)((bf16*)XC + (size_t)(row0 + t) * 1024 + chx) = pk2(o0[i], o1[i]);
            const float wg = wgl[t];
            *(LAS bf16*)(xT + (2 * cpx) * 272 + t * 2) = (bf16)f2bf(o0[i] * wg); *(LAS bf16*)(xT + (2 * cpx + 1) * 272 + t * 2) = (bf16)f2bf(o1[i] * wg); }
    }
    {
        float o0[16], o1[16];
        conv_apply<16>(rb, wb, bb2, o0, o1);
        const bool st = (h & 3) == 0;
#pragma unroll
        for (int i = 0; i < 16; ++i) { const int t = t0b + i; if (st) *(unsigned*)((bf16*)XC + (size_t)(row0 + t) * 1024 + chb) = pk2(o0[i], o1[i]);
            *(LAS bf16*)(BT + (2 * cpb) * 272 + t * 2) = (bf16)f2bf(o0[i]); *(LAS bf16*)(BT + (2 * cpb + 1) * 272 + t * 2) = (bf16)f2bf(o1[i]); }
    }
    if (doC) {
        float o0[16], o1[16];
        conv_apply<16>(rc, wc4, bc2, o0, o1);
#pragma unroll
        for (int i = 0; i < 16; ++i) *(unsigned*)((bf16*)XC + (size_t)(row0 + t0b + i) * 1024 + chc) = pk2(o0[i], o1[i]);
    }
    __syncthreads();
    {
        float* Sp = ST + (size_t)((b * 16 + c) * 8 + h) * 64 * 128;
#pragma unroll
        for (int pt = 0; pt < 4; ++pt) {
            f32x4 acc = {0.f, 0.f, 0.f, 0.f};
            acc = mma_lds<128>(acc, xT + pt * 16 * 272, 272, BT + wave * 16 * 272, 272, lane);
#pragma unroll
            for (int r = 0; r < 4; ++r) Sp[(size_t)(pt * 16 + 4 * (lane >> 4) + r) * 128 + wave * 16 + (lane & 15)] = acc[r];
        }
    }
    __syncthreads();
}

static __device__ __noinline__ void cf_unit(LAS unsigned char* lds, int tid, int lane, int wave, int u, int layer) {
    unsigned char* ws = ARGWS_G(); const float* ccw = ARGF_G(I_CCW) + (size_t)layer * 31 * 512; const float* ccb = ARGF_G(I_CCB) + layer * 512; const float* clw = ARGF_G(I_CLW) + layer * 512; const float* clb = ARGF_G(I_CLB) + layer * 512;
    const bf16* P = (const bf16*)(ws + WS_P); bf16* MIX = (bf16*)(ws + WS_MIX);
    const int row0 = u * 32, tseq0 = row0 & (SEQ - 1), c = tid;
    LAS float* ul = (LAS float*)lds;
    {
        v4u av[8], gv[8];
#pragma unroll
        for (int k = 0; k < 8; ++k) { const int it = tid + 512 * k, i = it >> 6, cg = (it & 63) * 8; const int ri = (tseq0 - 30 + i >= 0) ? (row0 - 30 + i) : row0;
            const bf16* pr = P + (size_t)ri * NP + PC_G + cg; av[k] = (it < 62 * 64) ? *(const v4u*)pr : (v4u){0u, 0u, 0u, 0u}; gv[k] = (it < 62 * 64) ? *(const v4u*)(pr + 512) : (v4u){0u, 0u, 0u, 0u}; }
#pragma unroll
        for (int k = 0; k < 8; ++k) { const int it = tid + 512 * k, i = it >> 6, cg = (it & 63) * 8;
            if (it < 62 * 64) {
                const float z = (tseq0 - 30 + i >= 0) ? 1.0f : 0.0f;
                const f32x4 u0 = (f32x4){bflo(av[k].x) * sigmoidf_(bflo(gv[k].x)), bfhi(av[k].x) * sigmoidf_(bfhi(gv[k].x)), bflo(av[k].y) * sigmoidf_(bflo(gv[k].y)), bfhi(av[k].y) * sigmoidf_(bfhi(gv[k].y))} * z;
                const f32x4 u1 = (f32x4){bflo(av[k].z) * sigmoidf_(bflo(gv[k].z)), bfhi(av[k].z) * sigmoidf_(bfhi(gv[k].z)), bflo(av[k].w) * sigmoidf_(bflo(gv[k].w)), bfhi(av[k].w) * sigmoidf_(bfhi(gv[k].w))} * z;
                *(LAS f32x4*)(ul + i * 512 + cg) = u0; *(LAS f32x4*)(ul + i * 512 + cg + 4) = u1; } }
    }
    float wt[31];
#pragma unroll
    for (int j = 0; j < 31; ++j) wt[j] = ccw[j * 512 + c];
    const float bias = ccb[c];
    __syncthreads();
    float uu[62];
#pragma unroll
    for (int i = 0; i < 62; ++i) uu[i] = ul[i * 512 + c];
    float o[32];
#pragma unroll
    for (int i = 0; i < 32; ++i) o[i] = bias;
#pragma unroll
    for (int j = 0; j < 31; ++j) {
#pragma unroll
        for (int i = 0; i < 32; ++i) o[i] += wt[j] * uu[i + j]; }
    __syncthreads();
    LAS float* ol = (LAS float*)lds;
#pragma unroll
    for (int i = 0; i < 32; ++i) ol[i * 512 + c] = o[i];
    __syncthreads();
    const f32x4 lw0 = *(const f32x4*)(clw + 8 * lane), lw1 = *(const f32x4*)(clw + 8 * lane + 4), lb0 = *(const f32x4*)(clb + 8 * lane), lb1 = *(const f32x4*)(clb + 8 * lane + 4);
#pragma unroll
    for (int tt = 0; tt < 4; ++tt) {
        const int i = 4 * wave + tt;
        const f32x4 a = *(const LAS f32x4*)(ol + i * 512 + 8 * lane), bq = *(const LAS f32x4*)(ol + i * 512 + 8 * lane + 4);
        const float mu = wave_sum((a[0] + a[1]) + (a[2] + a[3]) + (bq[0] + bq[1]) + (bq[2] + bq[3])) * (1.0f / 512.0f);
        const f32x4 da = a - mu, db = bq - mu;
        const float var = wave_sum((da[0] * da[0] + da[1] * da[1]) + (da[2] * da[2] + da[3] * da[3]) + (db[0] * db[0] + db[1] * db[1]) + (db[2] * db[2] + db[3] * db[3])) * (1.0f / 512.0f);
        const float rstd = 1.0f / sqrtf(var + EPS);
        const f32x4 ha = da * rstd * lw0 + lb0, hb = db * rstd * lw1 + lb1;
        v4u w; w.x = pk2(siluf_(ha[0]), siluf_(ha[1])); w.y = pk2(siluf_(ha[2]), siluf_(ha[3])); w.z = pk2(siluf_(hb[0]), siluf_(hb[1])); w.w = pk2(siluf_(hb[2]), siluf_(hb[3]));
        *(v4u*)(MIX + (size_t)(row0 + i) * DM + 1536 + 8 * lane) = w;
    }
    __syncthreads();
}

__device__ __forceinline__ void ssd_scan(LAS unsigned char* lds, int tid, int vcu, int G) {
    unsigned char* ws = ARGWS_G();
    const float* ST = (const float*)(ws + WS_ST); const float* DEC = (const float*)(ws + WS_SMALL + SM_DEC); bf16* PREV = (bf16*)(ws + WS_ACT);
    for (int item = vcu; item < 256; item += G) {
        const int b = item >> 6, head = (item >> 3) & 7, pc = item & 7;
        if (tid < 256) {
            const int p = pc * 8 + (tid >> 5), n0 = (tid & 31) * 4;
            f32x4 st[16]; float dec[16];
#pragma unroll
            for (int c = 0; c < 16; ++c) { st[c] = *(const f32x4*)(ST + ((size_t)((b * 16 + c) * 8 + head) * 64 + p) * 128 + n0); dec[c] = DEC[(b * 16 + c) * 8 + head]; }
            f32x4 sacc = {0.f, 0.f, 0.f, 0.f};
#pragma unroll
            for (int c = 0; c < 16; ++c) { v2u w; w.x = pk2(sacc[0], sacc[1]); w.y = pk2(sacc[2], sacc[3]);
                *(v2u*)(PREV + ((size_t)((b * 16 + c) * 8 + head) * 64 + p) * 128 + n0) = w; sacc = sacc * dec[c] + st[c]; }
        }
    }
}

static __device__ __noinline__ void ssd2_part1(LAS unsigned char* lds, int tid, int lane, int wave, int u, int layer) {
    unsigned char* ws = ARGWS_G(); const float* sdp = ARGF_G(I_SD) + layer * 8; const float* snw = ARGF_G(I_SNW) + layer * 512;
    const int half = u & 1, g = (u >> 1) & 1, c = (u >> 2) & 15, b = u >> 6;
    const int row0 = b * SEQ + c * 128, tb = half * 64, SL = tb + 64;
    const bf16* P = (const bf16*)(ws + WS_P); bf16* MIX = (bf16*)(ws + WS_MIX); const float* XC = (const float*)(ws + WS_XC); float* YZ = (float*)(ws + WS_YZ);
    const float* DT = (const float*)(ws + WS_SMALL + SM_DT); const float* LAC = (const float*)(ws + WS_SMALL + SM_LAC); const bf16* PREV = (const bf16*)(ws + WS_ACT);
    LAS unsigned char* Cb = lds;
    LAS unsigned char* Bb = lds + 17408;
    LAS unsigned char* xsT = Bb;
    LAS unsigned char* prv = Bb + 17408;
    LAS float* Gf = (LAS float*)(lds + 52224);
    LAS unsigned char* Mh = lds + 85248;
    LAS float* dts = (LAS float*)(lds + 102656);
    LAS float* lcs = (LAS float*)(lds + 104704);
    LAS float* ssq = (LAS float*)(lds + 106752);
    const int q16 = lane & 15, gq = lane >> 4;
    {
        const int rr = tid >> 3, n0 = (tid & 7) * 16;
        v4u lc[2], lb0[2], lb1[2];
        { const bf16* src = (const bf16*)XC + (size_t)(row0 + tb + rr) * 1024 + 768 + g * 128 + n0;
          lc[0] = *(const v4u*)src; lc[1] = *(const v4u*)(src + 8); }
        { const bf16* src = (const bf16*)XC + (size_t)(row0 + rr) * 1024 + 512 + g * 128 + n0;
          lb0[0] = *(const v4u*)src; lb0[1] = *(const v4u*)(src + 8); lb1[0] = *(const v4u*)(src + (size_t)64 * 1024); lb1[1] = *(const v4u*)(src + (size_t)64 * 1024 + 8); }
        const float ldt = DT[(size_t)(row0 + (tid >> 2)) * 8 + g * 4 + (tid & 3)], llc = LAC[(size_t)(row0 + (tid >> 2)) * 8 + g * 4 + (tid & 3)];
        *(LAS v4u*)(Cb + rr * 272 + n0 * 2) = lc[0]; *(LAS v4u*)(Cb + rr * 272 + n0 * 2 + 16) = lc[1];
        *(LAS v4u*)(Bb + rr * 272 + n0 * 2) = lb0[0]; *(LAS v4u*)(Bb + rr * 272 + n0 * 2 + 16) = lb0[1];
        if (SL > 64) { *(LAS v4u*)(Bb + (rr + 64) * 272 + n0 * 2) = lb1[0]; *(LAS v4u*)(Bb + (rr + 64) * 272 + n0 * 2 + 16) = lb1[1]; }
        if (tid < SL * 4) { dts[tid] = ldt; lcs[tid] = llc; }
        if (tid < 64) ssq[tid] = 0.f;
    }
    __syncthreads();
    if (16 * wave < SL) {
#pragma unroll
        for (int tt = 0; tt < 4; ++tt) { f32x4 acc = {0.f, 0.f, 0.f, 0.f};
            acc = mma_lds<128>(acc, Cb + tt * 16 * 272, 272, Bb + wave * 16 * 272, 272, lane);
#pragma unroll
            for (int r = 0; r < 4; ++r) Gf[(tt * 16 + 4 * gq + r) * 129 + 16 * wave + q16] = acc[r]; }
    }
    __syncthreads();
}
static __device__ __noinline__ void ssd2_head(LAS unsigned char* lds, int tid, int lane, int wave, int u, int layer, int hh) {
    unsigned char* ws = ARGWS(); const float* sdp = ARGF(I_SD) + layer * 8; const float* snw = ARGF(I_SNW) + layer * 512;
    const int half = u & 1, g = (u >> 1) & 1, c = (u >> 2) & 15, b = u >> 6;
    const int row0 = b * SEQ + c * 128, tb = half * 64, SL = tb + 64;
    const bf16* P = (const bf16*)(ws + WS_P); bf16* MIX = (bf16*)(ws + WS_MIX); const float* XC = (const float*)(ws + WS_XC); float* YZ = (float*)(ws + WS_YZ);
    const float* DT = (const float*)(ws + WS_SMALL + SM_DT); const float* LAC = (const float*)(ws + WS_SMALL + SM_LAC); const bf16* PREV = (const bf16*)(ws + WS_ACT);
    LAS unsigned char* Cb = lds;
    LAS unsigned char* Bb = lds + 17408;
    LAS unsigned char* xsT = Bb;
    LAS unsigned char* prv = Bb + 17408;
    LAS float* Gf = (LAS float*)(lds + 52224);
    LAS unsigned char* Mh = lds + 85248;
    LAS float* dts = (LAS float*)(lds + 102656);
    LAS float* lcs = (LAS float*)(lds + 104704);
    LAS float* ssq = (LAS float*)(lds + 106752);
    const int q16 = lane & 15, gq = lane >> 4;
    float ssl[4] = {0.f, 0.f, 0.f, 0.f};
    const int tw = wave >> 1;
        const int head = g * 4 + hh;
        const int pq_ = tid >> 3, nq_ = (tid & 7) * 16;
        const bf16* sp_ = PREV + ((size_t)((b * 16 + c) * 8 + head) * 64 + pq_) * 128 + nq_;
        const v4u pw0 = *(const v4u*)sp_, pw1 = *(const v4u*)(sp_ + 8);
        const int sx_ = tid >> 2, px_ = (tid & 3) * 16, sxc_ = sx_ < SL ? sx_ : SL - 1;
        const bf16* xsrc_ = (const bf16*)XC + (size_t)(row0 + sxc_) * 1024 + head * 64 + px_;
        const v4u xq0_ = *(const v4u*)xsrc_, xq1_ = *(const v4u*)(xsrc_ + 8);
        const float Dh = sdp[head];
        float xv_[2][4]; unsigned zw_[2][4];
#pragma unroll
        for (int q2 = 0; q2 < 2; ++q2)
#pragma unroll
            for (int r = 0; r < 4; ++r) { const int tl = tb + (wave >> 1) * 16 + 4 * gq + r, p = (2 * (wave & 1) + q2) * 16 + q16;
                xv_[q2][r] = bf2f(((const bf16*)XC)[(size_t)(row0 + tl) * 1024 + head * 64 + p]); zw_[q2][r] = P[(size_t)(row0 + tl) * NP + PC_Z + head * 64 + p]; }
        *(LAS v4u*)(prv + pq_ * 272 + nq_ * 2) = pw0; *(LAS v4u*)(prv + pq_ * 272 + nq_ * 2 + 16) = pw1;
        if (sx_ < SL) {
#pragma unroll
            for (int q = 0; q < 8; ++q) { const unsigned wq = q < 4 ? (q == 0 ? xq0_.x : q == 1 ? xq0_.y : q == 2 ? xq0_.z : xq0_.w) : (q == 4 ? xq1_.x : q == 5 ? xq1_.y : q == 6 ? xq1_.z : xq1_.w);
                *(LAS bf16*)(xsT + (px_ + 2 * q) * 272 + sx_ * 2) = (bf16)(wq & 0xffffu); *(LAS bf16*)(xsT + (px_ + 2 * q + 1) * 272 + sx_ * 2) = (bf16)(wq >> 16); } }
        {
            const int t = tid >> 3, s0 = (tid & 7) * 16;
            if (s0 < SL) { const float lt = lcs[(tb + t) * 4 + hh]; unsigned w[8];
                float gv[16], lv[16], dv[16];
#pragma unroll
                for (int q = 0; q < 16; ++q) { gv[q] = Gf[t * 129 + s0 + q]; lv[q] = lcs[(s0 + q) * 4 + hh]; dv[q] = dts[(s0 + q) * 4 + hh]; }
#pragma unroll
                for (int q = 0; q < 8; ++q) { float v2[2];
#pragma unroll
                    for (int e = 0; e < 2; ++e) { const int s = s0 + 2 * q + e; const float val = gv[2 * q + e] * fexp(fminf(lt - lv[2 * q + e], 0.f)) * dv[2 * q + e]; v2[e] = (s <= tb + t) ? val : 0.f; }
                    w[q] = pk2(v2[0], v2[1]); }
                v4u w0, w1; w0.x = w[0]; w0.y = w[1]; w0.z = w[2]; w0.w = w[3]; w1.x = w[4]; w1.y = w[5]; w1.z = w[6]; w1.w = w[7];
                *(LAS v4u*)(Mh + t * 272 + s0 * 2) = w0; *(LAS v4u*)(Mh + t * 272 + s0 * 2 + 16) = w1; }
        }
        __syncthreads();
#pragma unroll
        for (int q2 = 0; q2 < 2; ++q2) {
            const int pp = 2 * (wave & 1) + q2;
            f32x4 yd = {0.f, 0.f, 0.f, 0.f}, yo = {0.f, 0.f, 0.f, 0.f};
            if (half) yd = mma_lds<128>(yd, Mh + tw * 16 * 272, 272, xsT + pp * 16 * 272, 272, lane);
            else yd = mma_lds<64>(yd, Mh + tw * 16 * 272, 272, xsT + pp * 16 * 272, 272, lane);
            yo = mma_lds<128>(yo, Cb + tw * 16 * 272, 272, prv + pp * 16 * 272, 272, lane);
#pragma unroll
            for (int r = 0; r < 4; ++r) {
                const int tl = tb + tw * 16 + 4 * gq + r, p = pp * 16 + q16;
                const float e = fexp(lcs[tl * 4 + hh]), xv = xv_[q2][r];
                const float y = yd[r] + e * yo[r] + Dh * xv;
                const float z = bf2f(zw_[q2][r]);
                const float v = y * siluf_(z);
                ssl[r] += v * v;
                YZ[(size_t)(row0 + tl) * 512 + head * 64 + p] = v;
            }
        }
        __syncthreads();
    LAS float* ssp = (LAS float*)(lds + 107008);
#pragma unroll
    for (int r = 0; r < 4; ++r) { float s = row16_sum(ssl[r]);
        if (q16 == 0) ssp[(hh * 2 + (wave & 1)) * 64 + tw * 16 + 4 * gq + r] = s; }
}
static __device__ __noinline__ void ssd2_finish(LAS unsigned char* lds, int tid, int lane, int wave, int u, int layer) {
    unsigned char* ws = ARGWS_G(); const float* sdp = ARGF_G(I_SD) + layer * 8; const float* snw = ARGF_G(I_SNW) + layer * 512;
    const int half = u & 1, g = (u >> 1) & 1, c = (u >> 2) & 15, b = u >> 6;
    const int row0 = b * SEQ + c * 128, tb = half * 64, SL = tb + 64;
    const bf16* P = (const bf16*)(ws + WS_P); bf16* MIX = (bf16*)(ws + WS_MIX); const float* XC = (const float*)(ws + WS_XC); float* YZ = (float*)(ws + WS_YZ);
    const float* DT = (const float*)(ws + WS_SMALL + SM_DT); const float* LAC = (const float*)(ws + WS_SMALL + SM_LAC); const bf16* PREV = (const bf16*)(ws + WS_ACT);
    LAS unsigned char* Cb = lds;
    LAS unsigned char* Bb = lds + 17408;
    LAS unsigned char* xsT = Bb;
    LAS unsigned char* prv = Bb + 17408;
    LAS float* Gf = (LAS float*)(lds + 52224);
    LAS unsigned char* Mh = lds + 85248;
    LAS float* dts = (LAS float*)(lds + 102656);
    LAS float* lcs = (LAS float*)(lds + 104704);
    LAS float* ssq = (LAS float*)(lds + 106752);
    const int q16 = lane & 15, gq = lane >> 4;
    const int tw = wave >> 1;
    const LAS float* ssp = (const LAS float*)(lds + 107008);
    __syncthreads();
    float vz[4][4][2], sw[4][2];
#pragma unroll
    for (int hh = 0; hh < 4; ++hh)
#pragma unroll
        for (int q2 = 0; q2 < 2; ++q2) { const int ch = g * 256 + hh * 64 + (2 * (wave & 1) + q2) * 16 + q16; sw[hh][q2] = snw[ch];
#pragma unroll
            for (int r = 0; r < 4; ++r) vz[hh][r][q2] = YZ[(size_t)(row0 + tb + tw * 16 + 4 * gq + r) * 512 + ch]; }
#pragma unroll
    for (int r = 0; r < 4; ++r) {
        const int t = tw * 16 + 4 * gq + r; float sq = 0.f;
#pragma unroll
        for (int k = 0; k < 8; ++k) sq += ssp[k * 64 + t];
        const float rstd = 1.0f / sqrtf(sq * (1.0f / 256.0f) + EPS);
#pragma unroll
        for (int hh = 0; hh < 4; ++hh)
#pragma unroll
            for (int q2 = 0; q2 < 2; ++q2) { const int ch = g * 256 + hh * 64 + (2 * (wave & 1) + q2) * 16 + q16;
                MIX[(size_t)(row0 + tb + t) * DM + 1024 + ch] = (bf16)f2bf(vz[hh][r][q2] * rstd * sw[hh][q2]); }
    }
    __syncthreads();
}

__device__ __forceinline__ void attn_tile(LAS unsigned char* lds, int tid, int lane, int wave, int b, int h, int t) {
    asm volatile("" : "+v"(tid), "+v"(lane));
    unsigned char* ws = (unsigned char*)ldarg_g(lds, 24);
    const bf16* P = (const bf16*)(ws + WS_P); bf16* MIX = (bf16*)(ws + WS_MIX); const float* kmean = (const float*)(ws + WS_SMALL + SM_KMEAN);
    const int i = t >> 1, hf = t & 1, q16 = lane & 15, gq = lane >> 4;
    const int qi = hf * 128 + 16 * wave + q16;
    const size_t qrow = (size_t)b * SEQ + i * 256 + qi;
    LAS float* kml = (LAS float*)(lds + 71680);
    for (int x = tid; x < 7 * 128; x += 512) kml[x] = kmean[(size_t)((b * 8 + h) * 8) * 128 + x];
    bf16x8 Qf[4];
#pragma unroll
    for (int ks = 0; ks < 4; ++ks) Qf[ks] = *(const bf16x8*)(P + qrow * NP + PC_Q + h * 128 + 32 * ks + 8 * gq);
    const int n_own = hf ? 4 : 2, n_it = n_own + 4 * i;
    v4u pk[2], pv[2];
#define TILE_ROWS(it) ((size_t)b * SEQ + ((it) < n_own ? i : (((it) - n_own) >> 2)) * 256 + ((it) < n_own ? (it) : (((it) - n_own) & 3)) * 64)
    {
        const size_t kr = TILE_ROWS(0);
#pragma unroll
        for (int e = 0; e < 2; ++e) { const int x = tid + 512 * e, key = x >> 4, c16 = x & 15; const bf16* src = P + (kr + key) * NP + h * 128 + c16 * 8; pk[e] = *(const v4u*)(src + PC_K); pv[e] = *(const v4u*)(src + PC_V); }
    }
    __syncthreads();
    unsigned sel;
    if (i <= 3) sel = (1u << i) - 1u;
    else {
        float gate[7];
#pragma unroll
        for (int j = 0; j < 7; ++j) { float s = 0.f;
            if (j < i) {
#pragma unroll
                for (int ks = 0; ks < 4; ++ks) { const f32x4 ka = *(const LAS f32x4*)(kml + j * 128 + 32 * ks + 8 * gq), kb = *(const LAS f32x4*)(kml + j * 128 + 32 * ks + 8 * gq + 4);
                    const bf16x8 qv = Qf[ks];
                    s += bf2f((unsigned short)qv[0]) * ka[0] + bf2f((unsigned short)qv[1]) * ka[1] + bf2f((unsigned short)qv[2]) * ka[2] + bf2f((unsigned short)qv[3]) * ka[3]
                       + bf2f((unsigned short)qv[4]) * kb[0] + bf2f((unsigned short)qv[5]) * kb[1] + bf2f((unsigned short)qv[6]) * kb[2] + bf2f((unsigned short)qv[7]) * kb[3]; }
            }
            s = xrow_sum(s); gate[j] = s; }
        sel = 0u;
#pragma unroll
        for (int rep = 0; rep < 3; ++rep) { float best = -INFINITY; int bj = 0;
#pragma unroll
            for (int j = 0; j < 7; ++j) if (j < i && !((sel >> j) & 1u) && gate[j] > best) { best = gate[j]; bj = j; }
            sel |= 1u << bj; }
    }
    {
#pragma unroll
        for (int e = 0; e < 2; ++e) { const int x = tid + 512 * e, key = x >> 4, c16 = x & 15; *(LAS v4u*)(lds + key * 272 + c16 * 16) = pk[e]; *(LAS v4u*)(lds + 17408 + key * 288 + c16 * 16) = pv[e]; }
    }
    __syncthreads();
    f32x4 O[8];
#pragma unroll
    for (int d = 0; d < 8; ++d) O[d] = (f32x4){0.f, 0.f, 0.f, 0.f};
    float mrun = -1e30f, lrun = 0.f;
    v4u pk1[2], pv1[2];
#define ATT_LOAD(PK, PV, TILE) do { const size_t kr_ = TILE_ROWS(TILE); _Pragma("unroll") for (int e = 0; e < 2; ++e) { const int x = tid + 512 * e, key = x >> 4, c16 = x & 15; \
        const bf16* src = P + (kr_ + key) * NP + h * 128 + c16 * 8; PK[e] = *(const v4u*)(src + PC_K); PV[e] = *(const v4u*)(src + PC_V); } } while (0)
#define ATT_STORE(PK, PV, BUF) do { LAS unsigned char* Kn_ = lds + (BUF) * 35840; _Pragma("unroll") for (int e = 0; e < 2; ++e) { const int x = tid + 512 * e, key = x >> 4, c16 = x & 15; \
        *(LAS v4u*)(Kn_ + key * 272 + c16 * 16) = PK[e]; *(LAS v4u*)(Kn_ + 17408 + key * 288 + c16 * 16) = PV[e]; } } while (0)
    if (n_it > 1) ATT_LOAD(pk1, pv1, 1);
#pragma unroll 1
    for (int it0 = 0; it0 < n_it; it0 += 2) {
#pragma unroll
      for (int par = 0; par < 2; ++par) {
        const int it = it0 + par, buf = par;
        if (it + 2 < n_it) { if (par == 0) ATT_LOAD(pk, pv, it + 2); else ATT_LOAD(pk1, pv1, it + 2); }
        const bool own = it < n_own; const int blk = own ? i : ((it - n_own) >> 2), kt = own ? it : ((it - n_own) & 3);
        const bool skip = own && (kt * 64 > hf * 128 + 16 * wave + 15);
        if (!skip) {
            const LAS unsigned char* Kl = lds + buf * 35840; const LAS unsigned char* Vl = Kl + 17408;
            f32x4 s[4];
            {
                bf16x8 kf[4][4];
#pragma unroll
                for (int T = 0; T < 4; ++T)
#pragma unroll
                    for (int ks = 0; ks < 4; ++ks) kf[T][ks] = *(const LAS bf16x8*)(Kl + (16 * T + q16) * 272 + ks * 64 + gq * 16);
                __builtin_amdgcn_sched_barrier(0);
#pragma unroll
                for (int T = 0; T < 4; ++T) { s[T] = __builtin_amdgcn_mfma_f32_16x16x32_bf16(kf[T][0], Qf[0], (f32x4){0.f, 0.f, 0.f, 0.f}, 0, 0, 0);
#pragma unroll
                    for (int ks = 1; ks < 4; ++ks) s[T] = __builtin_amdgcn_mfma_f32_16x16x32_bf16(kf[T][ks], Qf[ks], s[T], 0, 0, 0); }
                __builtin_amdgcn_sched_barrier(0);
            }
            if (own) {
#pragma unroll
                for (int T = 0; T < 4; ++T)
#pragma unroll
                    for (int r = 0; r < 4; ++r) if (kt * 64 + 16 * T + 4 * gq + r > qi) s[T][r] = -INFINITY;
            } else {
                const float bias = ((sel >> blk) & 1u) ? 0.f : -INFINITY;
#pragma unroll
                for (int T = 0; T < 4; ++T) s[T] += bias;
            }
            float mx = -INFINITY;
#pragma unroll
            for (int T = 0; T < 4; ++T) mx = fmaxf(mx, fmaxf(fmaxf(s[T][0], s[T][1]), fmaxf(s[T][2], s[T][3])));
            mx = xrow_max(mx);
            const float mnew = fmaxf(mrun, mx), alpha = __builtin_amdgcn_exp2f(mrun - mnew);
            mrun = mnew;
            float rs = 0.f;
#pragma unroll
            for (int T = 0; T < 4; ++T)
#pragma unroll
                for (int r = 0; r < 4; ++r) { const float p = __builtin_amdgcn_exp2f(s[T][r] - mnew); s[T][r] = p; rs += p; }
            rs = xrow_sum(rs);
            lrun = lrun * alpha + rs;
#pragma unroll
            for (int d = 0; d < 8; ++d) O[d] *= alpha;
#pragma unroll
            for (int k2 = 0; k2 < 2; ++k2) {
                bf16x8 pb; { const unsigned w0 = pg8::cvt_pk_bf16(s[2 * k2][0], s[2 * k2][1]), w1 = pg8::cvt_pk_bf16(s[2 * k2][2], s[2 * k2][3]), w2 = pg8::cvt_pk_bf16(s[2 * k2 + 1][0], s[2 * k2 + 1][1]), w3 = pg8::cvt_pk_bf16(s[2 * k2 + 1][2], s[2 * k2 + 1][3]);
                    const v4u wv = {w0, w1, w2, w3}; pb = __builtin_bit_cast(bf16x8, wv); }
                s16x4 v0[8], v1[8];
#pragma unroll
                for (int d = 0; d < 8; ++d) {
                    const LAS unsigned char* va0 = Vl + (32 * k2 + 4 * gq + (q16 >> 2)) * 288 + (16 * d + 4 * (q16 & 3)) * 2;
                    v0[d] = __builtin_amdgcn_ds_read_tr16_b64_v4i16((LAS s16x4*)va0);
                    v1[d] = __builtin_amdgcn_ds_read_tr16_b64_v4i16((LAS s16x4*)(va0 + 16 * 288));
                }
                __builtin_amdgcn_sched_barrier(0);
#pragma unroll
                for (int d = 0; d < 8; ++d) {
                    const bf16x8 va = {v0[d][0], v0[d][1], v0[d][2], v0[d][3], v1[d][0], v1[d][1], v1[d][2], v1[d][3]};
                    O[d] = __builtin_amdgcn_mfma_f32_16x16x32_bf16(va, pb, O[d], 0, 0, 0);
                }
                __builtin_amdgcn_sched_barrier(0);
            }
        }
        if (it + 1 < n_it) { if (par == 0) ATT_STORE(pk1, pv1, 1); else ATT_STORE(pk, pv, 0); }
        __syncthreads();
      }
    }
#undef ATT_LOAD
#undef ATT_STORE
    const float inv = 1.0f / lrun;
#pragma unroll
    for (int d = 0; d < 8; ++d) { v2u w; w.x = pk2(O[d][0] * inv, O[d][1] * inv); w.y = pk2(O[d][2] * inv, O[d][3] * inv);
        *(v2u*)(MIX + qrow * DM + h * 128 + 16 * d + 4 * gq) = w; }
    __syncthreads();
}

template <class Sched>
__device__ __forceinline__ void rs_table(LAS unsigned char* lds, unsigned char* ws, const Sched& S, int tid) {
    volatile LAS int* pml = (volatile LAS int*)(lds + RS_OFF - 16);
    if (tid == 0) { int n = 0; pml[0] = -1; pml[1] = -1; pml[2] = -1; pml[3] = -1; pg8::Unit uu;
        for (int i = 0; S.next(i, uu); ++i) { bool f = false; for (int k = 0; k < n; ++k) f |= (pml[k] == uu.pm); if (!f && n < 4) { pml[n] = uu.pm; ++n; } } }
    __syncthreads();
    const float* ssp = (const float*)(ws + WS_SMALL + SM_SS); LAS float* rst = (LAS float*)(lds + RS_OFF);
    int pmv[4]; f32x4 av[4][4];
#pragma unroll
    for (int sl = 0; sl < 4; ++sl) { pmv[sl] = pml[sl]; const int row = tid >> 1, hf = tid & 1;
        const GAS f32x4* p4 = (const GAS f32x4*)((const GAS float*)ssp + ((size_t)(max(pmv[sl], 0) * 256 + row) * 32 + hf * 16));
#pragma unroll
        for (int q = 0; q < 4; ++q) av[sl][q] = p4[q]; }
#pragma unroll
    for (int sl = 0; sl < 4; ++sl) { const int row = tid >> 1, hf = tid & 1;
        const f32x4 a0 = av[sl][0], a1 = av[sl][1], a2 = av[sl][2], a3 = av[sl][3];
        float sacc = ((a0[0] + a0[1]) + (a0[2] + a0[3])) + ((a1[0] + a1[1]) + (a1[2] + a1[3])) + ((a2[0] + a2[1]) + (a2[2] + a2[3])) + ((a3[0] + a3[1]) + (a3[2] + a3[3]));
        sacc += __shfl_xor(sacc, 1);
        if (hf == 0 && pmv[sl] >= 0) rst[sl * 256 + row] = 1.0f / sqrtf(sacc * (1.0f / DM) + EPS); }
    __syncthreads();
}

__global__ void __launch_bounds__(NWAVES * 64, 2) fwd_kernel(Args args) {
    extern __shared__ __attribute__((aligned(16))) unsigned char lds_raw[];
    LAS unsigned char* lds = (LAS unsigned char*)lds_raw;
    const int tid = threadIdx.x, lane = tid & 63, wave = __builtin_amdgcn_readfirstlane(tid >> 6);
    const int G = gridDim.x; const int bx = blockIdx.x; const int vcu = (G % 8 == 0) ? (bx % 8) * (G / 8) + bx / 8 : bx;
    volatile LAS unsigned* MISC = (volatile LAS unsigned*)(lds + MISC_OFF);
    for (int u = tid; u < (LDS_BYTES - MISC_OFF) / 4; u += NWAVES * 64) ((LAS unsigned*)(lds + MISC_OFF))[u] = 0u;
    __syncthreads();
    if (tid == 0) {
        LAS unsigned long long* at = (LAS unsigned long long*)(lds + ARGS_OFF);
#pragma unroll
        for (int k = 0; k < 23; ++k) at[k] = (unsigned long long)args.in[k];
        at[23] = (unsigned long long)args.out; at[24] = (unsigned long long)args.ws;
    }
    __syncthreads();
    static_assert(WS_CTL == 0 && CW_BAR == 4096 && MISC_OFF == 131072 && ARGS_OFF == 131072 + 1024, "grid_barrier() hard-codes these");
    if (!MK_PER_PHASE) { const XcdBarrier b0 = xcd_barrier_post((unsigned*)(ARGWS() + WS_CTL) + CW_BAR, MISC); if (tid == 0) MISC[2] = b0.x; __syncthreads(); }
    const int lo = args.ph_lo, hi = args.ph_hi;
#define IN(k) (lo <= (k) && (k) < hi)
#define NREP(k) (((PROBE_MASK >> (k)) & 1u) ? 2 : 1)
#define SEAM(k) do { if (!MK_PER_PHASE && IN(k) && ((k) + 1 < hi || rep_ + 1 < NREP(k))) grid_barrier(lds); } while (0)
    volatile LAS int* stb = (volatile LAS int*)(lds + SCHED_OFF);

#pragma unroll 1
    for (int rep_ = 0; rep_ < NREP(0); ++rep_) if (IN(0)) { p0_prologue(lds, tid, lane, wave, vcu, G); __syncthreads(); if (rep_ + 1 < NREP(0)) grid_barrier(lds); }

#pragma unroll 1
    for (int layer = 0; layer < 2; ++layer) {
        const int pb = 1 + 10 * layer;
        const bool moe = (layer & 1) != 0;

#pragma unroll 1
        for (int rep_ = 0; rep_ < NREP(pb + 0); ++rep_) if (layer == 0 && IN(pb + 0)) {
            unsigned char* ws = ARGWS();
            const float* hin = layer == 0 ? ARGF(I_X) : (const float*)(ws + WS_HB);
            norm_phase<0>(lds, tid, lane, wave, vcu, G, hin, ARGF(I_NMIX) + layer * DM, (bf16*)(ws + WS_HN), ARGF(I_WIN) + (size_t)layer * DM * IN_DIM + 4608, IN_DIM,
                          ARGF(I_SDTB) + layer * 8, (float*)(ws + WS_SMALL + SM_DT), nullptr, nullptr, nullptr, nullptr);
            SEAM(pb + 0);
        }
#pragma unroll 1
        for (int rep_ = 0; rep_ < NREP(pb + 1); ++rep_) if (IN(pb + 1)) {
            unsigned char* ws = ARGWS();
            pg8::Gemm g{(const bf16*)(ws + (layer ? WS_HB : WS_HN)), (const bf16*)(ws + WS_WIN) + (size_t)layer * NP * DM, M, NP, DM};     pg8::StaticOrder S; S.init(M, layer ? NP + 256 : NP, G, bx);
            pg8::EpiInproj E{(bf16*)(ws + WS_P), NP, (const float*)(ws + WS_ROPE), 0.08838834764831845f * 1.4426950408889634f, layer ? (const LAS unsigned char*)(lds + RS_OFF) : nullptr};
            if (layer) rs_table(lds, ws, S, tid);
            const bool cvA = ((bx >> 3) & 1) == 0; const int cvw = (((bx >> 4) << 3) | (bx & 7)) * NWAVES + wave, cvh = (G * NWAVES) >> 1;
            constexpr int IT_E1 = IT_IN + (IT_EARLY - IT_IN) / 2;
            if (layer == 0 && rep_ == 0 && cvA) { cv_run(lds, lds + wave * 16384, lane, IT_IN + cvw, cvh, IT_E1); __syncthreads(); }
            pg8::gemm_phase<pg8::EpiInproj, pg8::StaticOrder, true, true>(lds, g, S, E);
            if (layer == 0 && rep_ == 0 && !cvA) { __syncthreads(); cv_run(lds, lds + wave * 16384, lane, IT_E1 + cvw, cvh, IT_EARLY); __syncthreads(); }
            SEAM(pb + 1);
        }
#pragma unroll 1
        for (int rep_ = 0; rep_ < NREP(pb + 2); ++rep_) if (IN(pb + 2)) {
            for (int r2 = 0; r2 < (PROBE_SUB == 3 ? 2 : 1); ++r2)
            for (int u = vcu; u < 224; u += G) kmean_unit(lds, tid, u, (const bf16*)(ARGWS() + WS_P), (float*)(ARGWS() + WS_SMALL + SM_KMEAN));
            for (int r2 = 0; r2 < (PROBE_SUB == 4 ? 2 : 1); ++r2)
            for (int u = vcu; u < 512; u += G) ssd1_unit(lds, tid, lane, wave, u, layer);
            for (int r2 = 0; r2 < (PROBE_SUB == 5 ? 2 : 1); ++r2)
            for (int u = vcu; u < 256; u += G) cf_unit(lds, tid, lane, wave, u, layer);
            SEAM(pb + 2);
        }
#pragma unroll 1
        for (int rep_ = 0; rep_ < NREP(pb + 3); ++rep_) if (IN(pb + 3)) {
            ssd_scan(lds, tid, vcu, G); grid_barrier(lds);
            for (int r2 = 0; r2 < (PROBE_SUB == 1 ? 2 : 1); ++r2)
            for (int u = vcu; u < 256; u += G) { const int b = u >> 6, h = (u >> 3) & 7, pi = u & 7;
#pragma unroll 1
                for (int tt = 0; tt < 2; ++tt) attn_tile(lds, tid, lane, wave, b, h, tt ? 15 - pi : pi); }
            for (int r2 = 0; r2 < (PROBE_SUB == 2 ? 2 : 1); ++r2)
            for (int u = vcu; u < 256; u += G) { ssd2_part1(lds, tid, lane, wave, u, layer); for (int hh = 0; hh < 4; ++hh) ssd2_head(lds, tid, lane, wave, u, layer, hh); ssd2_finish(lds, tid, lane, wave, u, layer); }
            SEAM(pb + 3);
        }
#pragma unroll 1
        for (int rep_ = 0; rep_ < NREP(pb + 4); ++rep_) if (IN(pb + 4)) {
            unsigned char* ws = ARGWS();
            const float* hin = layer == 0 ? ARGF(I_X) : (const float*)(ws + WS_HB);
            pg8::Gemm g{(const bf16*)(ws + WS_MIX), (const bf16*)(ws + WS_WOUT) + (size_t)layer * DM * DM, M, DM, DM}; pg8::StaticOrder S; S.init(M, DM, G, bx);
            pg8::EpiRes E{hin, (float*)(ws + WS_HA), moe ? DM : -DM, 1.0f, nullptr};
            pg8::gemm_phase<pg8::EpiRes, pg8::StaticOrder, false, true>(lds, g, S, E);
            SEAM(pb + 4);
        }
#pragma unroll 1
        for (int rep_ = 0; rep_ < NREP(pb + 5); ++rep_) if (moe && IN(pb + 5)) {
            unsigned char* ws = ARGWS();
            norm_phase<1>(lds, tid, lane, wave, vcu, G, (const float*)(ws + WS_HA), ARGF(I_NFFN) + layer * DM, (bf16*)(ws + WS_HN8), ARGF(I_RT) + (size_t)(layer >> 1) * DM * NE, NE, nullptr, nullptr,
                               (int*)(ws + WS_SMALL + SM_TOKE), (f32x2*)(ws + WS_SMALL + SM_TOKG), (int*)(ws + WS_SMALL + SM_WCNT), (int*)(ws + WS_SMALL + SM_BCNT));
            SEAM(pb + 5);
        }
#pragma unroll 1
        for (int rep_ = 0; rep_ < NREP(pb + 6); ++rep_) if (moe && IN(pb + 6)) { gather_phase(lds, tid, lane, wave, vcu, G); SEAM(pb + 6); }
        if (IN(pb + 7) || IN(pb + 8)) {
            __syncthreads();
            if (tid == 0) {
                if (!moe) { stb[0] = 4; for (int g2 = 0; g2 < 4; ++g2) { stb[32 + g2] = 8; stb[40 + g2] = 8 * g2; } }
                else { const GAS int* et = (const GAS int*)(ARGWS_G() + WS_SMALL + SM_ETOT); typedef int i32x4_ __attribute__((ext_vector_type(4)));
                    const i32x4_ ea = *(const GAS i32x4_*)et, eb = *(const GAS i32x4_*)(et + 4);
                    stb[0] = 8; int mb = 0;
#pragma unroll
                    for (int e = 0; e < 8; ++e) { const int mt = ((e < 4 ? ea[e & 3] : eb[e & 3]) + 255) >> 8; stb[32 + e] = mt; stb[40 + e] = mb; mb += mt; } }
            }
            __syncthreads();
        }
#pragma unroll 1
        for (int rep_ = 0; rep_ < NREP(pb + 7); ++rep_) if (IN(pb + 7)) {
            if (tid == 0) { const int ng = stb[0]; int cum = 0; for (int g2 = 0; g2 < ng; ++g2) { stb[48 + g2] = cum; cum += stb[32 + g2] * 56; stb[64 + g2] = (moe ? g2 : 0) * 56; } stb[48 + ng] = cum; stb[80] = cum; stb[81] = 1; }
            __syncthreads();
            unsigned char* ws = ARGWS();
            pg8::GroupOrder S; S.tb = (const LAS int*)stb; S.G = G; S.c = bx; S.nwg = __builtin_amdgcn_readfirstlane(stb[48 + stb[0]]);
            if (!moe) {
                const bool cvFirst = ((bx >> 3) & 1) == 0; const int half = (G * NWAVES) >> 1;
                const int cw = (((bx >> 4) << 3) | (bx & 7)) * NWAVES + wave;
                constexpr int IT_MID = IT_EARLY + 4 * IT_FF;
                if (cvFirst && rep_ == 0) { cv_run(lds, lds + wave * 16384, lane, IT_EARLY + cw, half, IT_MID); __syncthreads(); }
                rs_table(lds, ws, S, tid);
                pg8::Gemm g{(const bf16*)(ws + WS_HN8), (const bf16*)(ws + WS_WGU), 0, 0, DM / 2};
                pg8::EpiSwiglu8 E{ws + WS_ACT, DFF, 0.0078125f, 0.0078125f, true, (const LAS unsigned char*)(lds + RS_OFF)};
                pg8::gemm_phase<pg8::EpiSwiglu8, pg8::GroupOrder, true, true, true>(lds, g, S, E);
                if (!cvFirst && rep_ == 0) { __syncthreads(); cv_run(lds, lds + wave * 16384, lane, IT_MID + cw, half, IT_TOTAL); __syncthreads(); }
            } else {
                pg8::Gemm g{(const bf16*)(ws + WS_XP8), (const bf16*)(ws + WS_WGU8), 0, 0, DM / 2};
                pg8::EpiSwiglu8 E{ws + WS_ACT8, DFF, 0.0078125f, 0.0625f, false, nullptr};
                pg8::gemm_phase<pg8::EpiSwiglu8, pg8::GroupOrder, true, true, true>(lds, g, S, E);
            }
            SEAM(pb + 7);
        }
#pragma unroll 1
        for (int rep_ = 0; rep_ < NREP(pb + 8); ++rep_) if (IN(pb + 8)) {
            __syncthreads();
            if (tid == 0) { const int ng = stb[0]; int cum = 0; for (int g2 = 0; g2 < ng; ++g2) { stb[48 + g2] = cum; cum += stb[32 + g2] * 8; stb[64 + g2] = (moe ? g2 : 0) * 8; } stb[48 + ng] = cum;
                const int R = cum % G; int S = 1; if (moe && cum > G && R > 0) { if (4 * R <= G) S = 4; else if (2 * R <= G) S = 2; }
                stb[80] = S > 1 ? cum - R : cum; stb[81] = S; }
            __syncthreads();
            unsigned char* ws = ARGWS();
            pg8::GroupOrder S; S.tb = (const LAS int*)stb; S.G = G; S.c = bx; { const int tot = stb[48 + stb[0]], nf = stb[80]; S.nwg = __builtin_amdgcn_readfirstlane(nf + (tot - nf) * stb[81]); }
            if (!moe) {
                pg8::Gemm g{(const bf16*)(ws + WS_ACT), (const bf16*)(ws + WS_WDN), 0, 0, DFF};
                pg8::EpiRes E{(const float*)(ws + WS_HA), (float*)(ws + WS_HB), -(DM + 1), 1.0f, nullptr};
                pg8::gemm_phase<pg8::EpiRes, pg8::GroupOrder, false, true, false>(lds, g, S, E);
            } else {
                pg8::Gemm g{(const bf16*)(ws + WS_ACT8), (const bf16*)(ws + WS_WDN8), 0, 0, DFF / 2};
                pg8::EpiRes E{nullptr, (float*)(ws + WS_YT), DM, 1.0f / 1024.0f, (bf16*)(ws + WS_Y)};
                pg8::gemm_phase<pg8::EpiRes, pg8::GroupOrder, false, true, true>(lds, g, S, E);
            }
            SEAM(pb + 8);
        }
#pragma unroll 1
        for (int rep_ = 0; rep_ < NREP(pb + 9); ++rep_) if (moe && IN(pb + 9)) { combine_phase(lds, lane, wave, vcu, G); if (rep_ + 1 < NREP(pb + 9)) grid_barrier(lds); }
    }
#undef IN
#undef SEAM
}

extern "C" void kernel_launch(void* const* d_in, const int* in_sizes, int n_in, void* d_out, int out_size, void* d_ws, size_t ws_size, hipStream_t stream) {
    static int grid = 0;
    if (grid == 0) {
        if (n_in != 23 || out_size != M * DM || ws_size < WS_END) { fprintf(stderr, "kernel_launch: unexpected problem (n_in %d, out %d, ws %zu < %zu)\n", n_in, out_size, ws_size, (size_t)WS_END); grid = -1; return; }
        int dev = 0, cus = 0, per_cu = 0;
        if (hipGetDevice(&dev) != hipSuccess || hipDeviceGetAttribute(&cus, hipDeviceAttributeMultiprocessorCount, dev) != hipSuccess) { grid = -1; return; }
        if (hipFuncSetAttribute((const void*)fwd_kernel, hipFuncAttributeMaxDynamicSharedMemorySize, LDS_BYTES) != hipSuccess) { fprintf(stderr, "kernel_launch: hipFuncSetAttribute failed\n"); grid = -1; return; }
        if (hipOccupancyMaxActiveBlocksPerMultiprocessor(&per_cu, (const void*)fwd_kernel, NWAVES * 64, LDS_BYTES) != hipSuccess || per_cu < 1) fprintf(stderr, "kernel_launch: occupancy query reports %d\n", per_cu);
        (void)hipGetLastError();
        grid = cus;
    }
    if (grid < 0) return;
    if (hipMemsetAsync((char*)d_ws + WS_CTL, 0, CTL_ZERO_BYTES, stream) != hipSuccess) return;
    Args a{};
    for (int i = 0; i < 23; ++i) a.in[i] = (const float*)d_in[i];
    a.out = (float*)d_out; a.ws = (unsigned char*)d_ws;
#if MK_PER_PHASE
    for (int ph = 0; ph < 21; ++ph) {
        if (ph == 7 || ph == 10) continue;
        a.ph_lo = ph; a.ph_hi = ph + 1;
        hipLaunchKernelGGL(fwd_kernel, dim3(grid), dim3(NWAVES * 64), LDS_BYTES, stream, a);
    }
#else
    a.ph_lo = 0; a.ph_hi = 21;
    hipLaunchKernelGGL(fwd_kernel, dim3(grid), dim3(NWAVES * 64), LDS_BYTES, stream, a);
#endif
}
```

```cpp
#include <hip/hip_runtime.h>
#include <cstdio>
#include <cstdint>

#ifndef PROBE_MASK
#define PROBE_MASK 0u
#endif
#define PROBE_SUB 0
#ifndef MK_PER_PHASE
#define MK_PER_PHASE 0
#endif

constexpr int DM = 2048, NBATCH = 4, SEQ = 2048, M = NBATCH * SEQ;
constexpr int IN_DIM = 5640, NP = 5632;
constexpr int DFF = 7168, NE = 8, MPMAX = 72 * 256;
constexpr int NWAVES = 8;
constexpr float EPS = 1e-5f;
constexpr int PC_Q = 0, PC_K = 1024, PC_V = 2048, PC_Z = 3072, PC_X = 3584, PC_G = 4608;

constexpr size_t MiB = 1u << 20;
constexpr size_t WS_CTL = 0, CTL_ZERO_BYTES = 32 * 1024;
constexpr size_t WS_ROPE = 1 * MiB;
constexpr size_t WS_SMALL = 2 * MiB;
constexpr size_t WS_WIN = 4 * MiB;
constexpr size_t WS_WOUT = WS_WIN + 45 * MiB;
constexpr size_t WS_WGU = WS_WOUT + 16 * MiB;
constexpr size_t WS_WGU8 = WS_WGU + 56 * MiB;
constexpr size_t WS_WDN = WS_WGU8 + 224 * MiB;
constexpr size_t WS_WDN8 = WS_WDN + 28 * MiB;
constexpr size_t WS_HA = WS_WDN8 + 112 * MiB;
constexpr size_t WS_HB = WS_HA + 64 * MiB;
constexpr size_t WS_HN = WS_HB + 64 * MiB;
constexpr size_t WS_P = WS_HN + 32 * MiB;
constexpr size_t WS_MIX = WS_P + 88 * MiB;
constexpr size_t WS_ACT = WS_MIX + 32 * MiB;
constexpr size_t WS_YT = WS_ACT + 16 * MiB;
constexpr size_t WS_ACT8 = WS_ACT + 112 * MiB;
constexpr size_t WS_XP8 = WS_ACT8 + 126 * MiB;
constexpr size_t WS_HN8 = WS_XP8 + 36 * MiB;
constexpr size_t WS_Y = WS_HN8 + 16 * MiB;
constexpr size_t WS_XC = WS_Y + 144 * MiB;
constexpr size_t WS_ST = WS_XC + 32 * MiB;
constexpr size_t WS_YZ = WS_ST + 16 * MiB;
constexpr size_t WS_END = WS_YZ + 16 * MiB;
static_assert(WS_END <= 1792 * MiB, "d_ws map must fit 4 x the largest input tensor (1792 MiB)");
constexpr size_t SM_DT = 0;
constexpr size_t SM_LAC = 256 * 1024;
constexpr size_t SM_DEC = 512 * 1024;
constexpr size_t SM_KMEAN = 520 * 1024;
constexpr size_t SM_TOKE = 656 * 1024;
constexpr size_t SM_TOKG = 688 * 1024;
constexpr size_t SM_POS = 752 * 1024;
constexpr size_t SM_WCNT = 816 * 1024;
constexpr size_t SM_BCNT = 880 * 1024;
constexpr size_t SM_ETOT = 888 * 1024;
constexpr size_t SM_NWC = 896 * 1024;
constexpr size_t SM_SS = 1024 * 1024;
constexpr int RS_OFF = 131072 + 4096;
constexpr int CW_BAR = 4096;
constexpr int RING_BYTES = 131072, MISC_OFF = 131072, SCHED_OFF = MISC_OFF + 256, LDS_BYTES = 147456;

namespace pg8 {
#define PG8_LAS __attribute__((address_space(3)))
#define PG8_GAS __attribute__((address_space(1)))
typedef unsigned short bf16_t;
typedef short bf16x8 __attribute__((ext_vector_type(8)));
typedef float f32x4 __attribute__((ext_vector_type(4)));
typedef unsigned u32x4 __attribute__((ext_vector_type(4)));
constexpr int BM = 256, BK = 64, HALF = 128, HTB = HALF * BK * 2, STAGE_BYTES = 8 * HTB, NXCD = 8, WGM = 8;

__host__ __device__ __forceinline__ int lds_byte(int r, int c) { const int st = (r >> 4) * 2 + (c >> 5), rr = r & 15, cc = c & 31, ob = rr * 64 + cc * 2; return st * 1024 + (ob ^ (((ob >> 9) & 1) << 5)); }
__host__ __device__ __forceinline__ void stage_rc(int b, int& R, int& C) { const int st = b / 1024, sb = b % 1024, swz = sb ^ (((sb >> 9) & 1) << 5); R = (st >> 1) * 16 + swz / 64; C = (st & 1) * 32 + (swz % 64) / 2; }
__host__ __device__ __forceinline__ int perm32(int rho) { const int n = rho >> 4, i = rho & 15; return 8 * (i >> 2) + 4 * n + (i & 3); }

struct Unit { int pm, pn, pnl, sk; __device__ __forceinline__ int kp() const { return sk & 0xff; } __device__ __forceinline__ int ks() const { return (sk >> 8) & 0xff; } __device__ __forceinline__ int tl() const { return (sk >> 16) - 1; } };
struct Gemm { const bf16_t* A; const bf16_t* Bt; int M, N, K; };

struct StaticOrder {
    int nM, nN, nwg, G, c;
    __device__ void init(int M, int N, int G_, int c_) { nM = M / BM; nN = N / BM; nwg = nM * nN; G = G_; c = c_; }
    __device__ __forceinline__ bool next(int i, Unit& u) const {
        const long L = (long)i * G + c; if (L >= nwg) return false;
        int wgid = (int)L; { const int q = nwg / NXCD, r = nwg % NXCD, xcd = wgid % NXCD, off = wgid / NXCD; wgid = (xcd < r ? xcd * (q + 1) : r * (q + 1) + (xcd - r) * q) + off; }
        const int nig = WGM * nN, gid = wgid / nig, fm = gid * WGM, gsz = (nM - fm) < WGM ? (nM - fm) : WGM;
        u.pm = fm + ((wgid % nig) % gsz); u.pn = (wgid % nig) / gsz; u.pnl = u.pn; u.sk = 0x100; return true;
    }
    __device__ __forceinline__ void a_ready(const Unit&) const {}
    __device__ __forceinline__ void done(const Unit&) const {}
};
struct GroupOrder {
    const PG8_LAS int* tb; int G, c, nwg;
    __device__ __forceinline__ bool next(int i, Unit& u) const {
        const long L = (long)i * G + c; if (L >= nwg) return false;
        const int nfull = tb[80], S = tb[81]; int kp = 0, tl = -1;
        int wgid = (int)L;
        if (wgid < nfull) { const int q = nfull / NXCD, r = nfull % NXCD, xcd = wgid % NXCD, off = wgid / NXCD; wgid = (xcd < r ? xcd * (q + 1) : r * (q + 1) + (xcd - r) * q) + off; }
        else { const int v = wgid - nfull; tl = v / S; kp = v - tl * S; wgid = nfull + tl; }
        const int ng = tb[0]; int g = 0;
        for (int k = 1; k < 8; ++k) if (k < ng && wgid >= tb[48 + k]) g = k;
        const int r = wgid - tb[48 + g], mt = tb[32 + g], pnl = r / mt, pm = tb[40 + g] + (r - pnl * mt);
        u.pm = __builtin_amdgcn_readfirstlane(pm); u.pnl = __builtin_amdgcn_readfirstlane(pnl); u.pn = __builtin_amdgcn_readfirstlane(tb[64 + g] + pnl);
        u.sk = __builtin_amdgcn_readfirstlane(kp | ((tl >= 0 ? S : 1) << 8) | ((tl + 1) << 16)); return true;
    }
    __device__ __forceinline__ void a_ready(const Unit&) const {}
    __device__ __forceinline__ void done(const Unit&) const {}
};

__device__ __forceinline__ float xrow_sum4(float v) {
    { const unsigned x = __builtin_bit_cast(unsigned, v); const auto r = __builtin_amdgcn_permlane32_swap(x, x, false, false); v = __builtin_bit_cast(float, (unsigned)r[0]) + __builtin_bit_cast(float, (unsigned)r[1]); }
    { const unsigned x = __builtin_bit_cast(unsigned, v); const auto r = __builtin_amdgcn_permlane16_swap(x, x, false, false); v = __builtin_bit_cast(float, (unsigned)r[0]) + __builtin_bit_cast(float, (unsigned)r[1]); }
    return v; }
__device__ __forceinline__ unsigned cvt_pk_bf16(float lo, float hi) { unsigned r; asm volatile("v_cvt_pk_bf16_f32 %0, %1, %2" : "=v"(r) : "v"(lo), "v"(hi)); return r; }

struct EpiInproj {
    static constexpr bool PERM = true, AFTER_DRAIN = false;
    bf16_t* O; int ldc; const float* rope; float qscale;
    const PG8_LAS unsigned char* rsb;
    __device__ __forceinline__ void operator()(const f32x4 (&acc)[2][2][4][2], const Unit& u, int wr, int wc, int fr, int fq) const {
        const int row0 = u.pm * BM + wr * 64 + fr;
        const PG8_LAS float* rst = nullptr;
        if (rsb) { const int sl = ((const PG8_LAS int*)(rsb - 32 - 128))[u.pm];
            rst = (const PG8_LAS float*)rsb + sl * 256 + wr * 64 + fr; }
        if (u.pn == 22) {
            if (wc == 0 && fq == 0) {
                unsigned char* wsb = (unsigned char*)O - WS_P; const float* bia = (const float*)(wsb + WS_SMALL + SM_NWC) + 2 * DM; float* dto = (float*)(wsb + WS_SMALL + SM_DT);
                const f32x4 b0 = *(const f32x4*)bia, b1 = *(const f32x4*)(bia + 4);
#pragma unroll
                for (int ai = 0; ai < 2; ++ai)
#pragma unroll
                    for (int m = 0; m < 4; ++m) { const float r = rst[ai * HALF + m * 16]; f32x4 x0 = acc[ai][0][m][0] * r + b0, x1 = acc[ai][0][m][1] * r + b1;
#pragma unroll
                        for (int j = 0; j < 4; ++j) { x0[j] = fmaxf(x0[j], 0.f) + 0.6931471805599453f * __builtin_amdgcn_logf(1.0f + __builtin_amdgcn_exp2f(-1.4426950408889634f * __builtin_fabsf(x0[j])));
                                                      x1[j] = fmaxf(x1[j], 0.f) + 0.6931471805599453f * __builtin_amdgcn_logf(1.0f + __builtin_amdgcn_exp2f(-1.4426950408889634f * __builtin_fabsf(x1[j]))); }
                        float* dp = dto + (size_t)(row0 + ai * HALF + m * 16) * 8; *(f32x4*)dp = x0; *(f32x4*)(dp + 4) = x1; }
            }
            return;
        }
        if (u.pn < 8) {
            const int part = u.pn >> 2, pl = u.pn & 3, head = 2 * pl + (wc >> 1), dlo = (wc & 1) * 32 + 8 * fq;
            const float sc0 = part == 0 ? qscale : 1.0f;
            const PG8_GAS float* grope = (const PG8_GAS float*)rope; PG8_GAS bf16_t* gO = (PG8_GAS bf16_t*)O;
            f32x4 rq[2][4];
#define PG8_RP_LD(G, D) do { const int pos_ = (row0 + ((G) >> 2) * HALF + ((G) & 3) * 16) & 2047; _Pragma("unroll") for (int q_ = 0; q_ < 4; ++q_) D[q_] = *(const PG8_GAS f32x4*)(grope + ((size_t)pos_ * 64 + dlo) * 2 + 4 * q_); } while (0)
            PG8_RP_LD(0, rq[0]);
#pragma unroll
            for (int g = 0; g < 8; ++g) { const int ai = g >> 2, m = g & 3;
                {
                    if (g + 1 < 8) PG8_RP_LD(g + 1, rq[(g + 1) & 1]);
                    const float sc = rsb ? sc0 * rst[ai * HALF + m * 16] : sc0;
                    const int row = row0 + ai * HALF + m * 16;
                    u32x4 w1, w2; unsigned o1[4], o2[4];
#pragma unroll
                    for (int n = 0; n < 2; ++n) {
                        const f32x4 cs0 = rq[g & 1][2 * n], cs1 = rq[g & 1][2 * n + 1];
                        const f32x4 x1 = acc[ai][0][m][n], x2 = acc[ai][1][m][n];
                        const float a0 = (x1[0] * cs0[0] - x2[0] * cs0[1]) * sc, a1 = (x1[1] * cs0[2] - x2[1] * cs0[3]) * sc;
                        const float a2 = (x1[2] * cs1[0] - x2[2] * cs1[1]) * sc, a3 = (x1[3] * cs1[2] - x2[3] * cs1[3]) * sc;
                        const float b0 = (x2[0] * cs0[0] + x1[0] * cs0[1]) * sc, b1 = (x2[1] * cs0[2] + x1[1] * cs0[3]) * sc;
                        const float b2 = (x2[2] * cs1[0] + x1[2] * cs1[1]) * sc, b3 = (x2[3] * cs1[2] + x1[3] * cs1[3]) * sc;
                        o1[2 * n] = cvt_pk_bf16(a0, a1); o1[2 * n + 1] = cvt_pk_bf16(a2, a3);
                        o2[2 * n] = cvt_pk_bf16(b0, b1); o2[2 * n + 1] = cvt_pk_bf16(b2, b3);
                    }
                    w1.x = o1[0]; w1.y = o1[1]; w1.z = o1[2]; w1.w = o1[3]; w2.x = o2[0]; w2.y = o2[1]; w2.z = o2[2]; w2.w = o2[3];
                    PG8_GAS bf16_t* rowp = gO + (size_t)row * ldc + part * 1024 + head * 128 + dlo;
                    *(PG8_GAS u32x4*)rowp = w1; *(PG8_GAS u32x4*)(rowp + 64) = w2;
                }
            }
        } else {
            const int col0 = u.pn * BM + wc * 32 + 8 * fq;
#pragma unroll
            for (int ai = 0; ai < 2; ++ai)
#pragma unroll
                for (int m = 0; m < 4; ++m) { PG8_GAS bf16_t* rowp = (PG8_GAS bf16_t*)O + (size_t)(row0 + ai * HALF + m * 16) * ldc + col0; const float r = rsb ? rst[ai * HALF + m * 16] : 1.0f;
#pragma unroll
                    for (int bj = 0; bj < 2; ++bj) { const f32x4 v0 = acc[ai][bj][m][0] * r, v1 = acc[ai][bj][m][1] * r;
                        u32x4 w; w.x = cvt_pk_bf16(v0[0], v0[1]); w.y = cvt_pk_bf16(v0[2], v0[3]); w.z = cvt_pk_bf16(v1[0], v1[1]); w.w = cvt_pk_bf16(v1[2], v1[3]);
                        *(PG8_GAS u32x4*)(rowp + bj * HALF) = w; } }
        }
    }
};
struct EpiSwiglu {
    static constexpr bool PERM = true, AFTER_DRAIN = false;
    bf16_t* O; int ldc;
    __device__ __forceinline__ void operator()(const f32x4 (&acc)[2][2][4][2], const Unit& u, int wr, int wc, int fr, int fq) const {
        const int row0 = u.pm * BM + wr * 64 + fr, col0 = u.pnl * HALF + wc * 32 + 8 * fq;
#pragma unroll
        for (int ai = 0; ai < 2; ++ai)
#pragma unroll
            for (int m = 0; m < 4; ++m) {
                float v[8];
#pragma unroll
                for (int n = 0; n < 2; ++n)
#pragma unroll
                    for (int j = 0; j < 4; ++j) { const float g = acc[ai][0][m][n][j], up = acc[ai][1][m][n][j];
                        v[4 * n + j] = g * __builtin_amdgcn_rcpf(1.0f + __builtin_amdgcn_exp2f(-1.4426950408889634f * g)) * up; }
                u32x4 w; w.x = cvt_pk_bf16(v[0], v[1]); w.y = cvt_pk_bf16(v[2], v[3]); w.z = cvt_pk_bf16(v[4], v[5]); w.w = cvt_pk_bf16(v[6], v[7]);
                *(u32x4*)(O + (size_t)(row0 + ai * HALF + m * 16) * ldc + col0) = w;
            }
    }
};
struct EpiSwiglu8 {
    static constexpr bool PERM = true, AFTER_DRAIN = false;
    unsigned char* O; int ldc; float gsc, usc;
    bool o16;
    const PG8_LAS unsigned char* rsb;
    __device__ __forceinline__ void operator()(const f32x4 (&acc)[2][2][4][2], const Unit& u, int wr, int wc, int fr, int fq) const {
        const int row0 = u.pm * BM + wr * 64 + fr, col0 = u.pnl * HALF + wc * 32 + 8 * fq;
        const float esc0 = -1.4426950408889634f * gsc, psc0 = gsc * usc;
        const PG8_LAS float* rst = nullptr;
        if (rsb) { const int sl = ((const PG8_LAS int*)(rsb - 32 - 128))[u.pm];
            rst = (const PG8_LAS float*)rsb + sl * 256 + wr * 64 + fr; }
#pragma unroll
        for (int ai = 0; ai < 2; ++ai)
#pragma unroll
            for (int m = 0; m < 4; ++m) {
                float esc = esc0, psc = psc0;
                if (rsb) { const float r = rst[ai * HALF + m * 16]; esc *= r; psc *= r * r; }
                const float c0 = __builtin_amdgcn_rcpf(psc);
                float v[8];
#pragma unroll
                for (int n = 0; n < 2; ++n)
#pragma unroll
                    for (int j = 0; j < 4; ++j) { const float a = acc[ai][0][m][n][j], b = acc[ai][1][m][n][j];
                        const float r = __builtin_amdgcn_rcpf(__builtin_fmaf(__builtin_amdgcn_exp2f(a * esc), c0, c0));
                        const float t = (a * b) * r;
                        v[4 * n + j] = o16 ? t : __builtin_amdgcn_fmed3f(t, -448.0f, 448.0f); }
                if (o16) { u32x4 w; w.x = cvt_pk_bf16(v[0], v[1]); w.y = cvt_pk_bf16(v[2], v[3]); w.z = cvt_pk_bf16(v[4], v[5]); w.w = cvt_pk_bf16(v[6], v[7]);
                    *(PG8_GAS u32x4*)((PG8_GAS bf16_t*)O + (size_t)(row0 + ai * HALF + m * 16) * ldc + col0) = w; continue; }
                int w0 = 0, w1 = 0;
                w0 = __builtin_amdgcn_cvt_pk_fp8_f32(v[0], v[1], w0, false); w0 = __builtin_amdgcn_cvt_pk_fp8_f32(v[2], v[3], w0, true);
                w1 = __builtin_amdgcn_cvt_pk_fp8_f32(v[4], v[5], w1, false); w1 = __builtin_amdgcn_cvt_pk_fp8_f32(v[6], v[7], w1, true);
                typedef int i32x2 __attribute__((ext_vector_type(2)));
                *(PG8_GAS i32x2*)((PG8_GAS unsigned char*)O + (size_t)(row0 + ai * HALF + m * 16) * ldc + col0) = (i32x2){w0, w1};
            }
    }
};
struct EpiRes {
    static constexpr bool PERM = false, AFTER_DRAIN = false;
    const float* base; float* out; int ldc; float scale; bf16_t* out16;
    __device__ __forceinline__ void operator()(const f32x4 (&acc)[2][2][4][2], const Unit& u, int wr, int wc, int fr, int fq) const {
        const int row0 = u.pm * BM + wr * 64 + fr, col0 = u.pnl * BM + wc * 32 + 4 * fq;
        if (ldc < 0) {
            const bool second = ldc != -DM; const int ld = DM;
            unsigned char* wsb = (unsigned char*)out - (second ? WS_HB : WS_HA);
            const float* nwc = (const float*)(wsb + WS_SMALL + SM_NWC) + (second ? DM : 0); bf16_t* an = (bf16_t*)(wsb + WS_HN); float* ssp = (float*)(wsb + WS_SMALL + SM_SS);
            const PG8_GAS float* gbase = (const PG8_GAS float*)base; PG8_GAS float* gout = (PG8_GAS float*)out; PG8_GAS bf16_t* gan = (PG8_GAS bf16_t*)an;
            PG8_GAS unsigned char* gan8 = (PG8_GAS unsigned char*)(wsb + WS_HN8); PG8_GAS float* gssp = (PG8_GAS float*)ssp; const PG8_GAS float* gnwc = (const PG8_GAS float*)nwc;
            f32x4 gw[2][2];
#pragma unroll
            for (int bj = 0; bj < 2; ++bj)
#pragma unroll
                for (int n = 0; n < 2; ++n) gw[bj][n] = second ? (f32x4){0.f, 0.f, 0.f, 0.f} : *(const PG8_GAS f32x4*)(gnwc + col0 + bj * HALF + n * 16);
            typedef unsigned u32x2_ __attribute__((ext_vector_type(2)));
            PG8_GAS bf16_t* gout16 = (PG8_GAS bf16_t*)out; const PG8_GAS bf16_t* gbase16 = (const PG8_GAS bf16_t*)base;
            f32x4 bq[2][4]; u32x2_ bh[2][4];
#define PG8_ER_LD(G, D) do { const size_t off_ = (size_t)(row0 + ((G) >> 2) * HALF + ((G) & 3) * 16) * ld + col0; _Pragma("unroll") for (int q_ = 0; q_ < 4; ++q_) D[q_] = *(const PG8_GAS f32x4*)(gbase + off_ + (q_ >> 1) * HALF + (q_ & 1) * 16); } while (0)
#define PG8_ER_LDH(G, D) do { const size_t off_ = (size_t)(row0 + ((G) >> 2) * HALF + ((G) & 3) * 16) * ld + col0; _Pragma("unroll") for (int q_ = 0; q_ < 4; ++q_) D[q_] = *(const PG8_GAS u32x2_*)(gbase16 + off_ + (q_ >> 1) * HALF + (q_ & 1) * 16); } while (0)
#define PG8_BF4(X) ((f32x4){__builtin_bit_cast(float, (X).x << 16), __builtin_bit_cast(float, (X).x & 0xffff0000u), __builtin_bit_cast(float, (X).y << 16), __builtin_bit_cast(float, (X).y & 0xffff0000u)})
            if (second) PG8_ER_LDH(0, bh[0]); else PG8_ER_LD(0, bq[0]);
#pragma unroll
            for (int g = 0; g < 8; ++g) { const int ai = g >> 2, m = g & 3;
                if (g + 1 < 8) { if (second) PG8_ER_LDH(g + 1, bh[(g + 1) & 1]); else PG8_ER_LD(g + 1, bq[(g + 1) & 1]); }
                const int row = row0 + ai * HALF + m * 16; const size_t off = (size_t)row * ld + col0; float sq = 0.f;
#pragma unroll
                for (int bj = 0; bj < 2; ++bj)
#pragma unroll
                    for (int n = 0; n < 2; ++n) { const f32x4 bv = second ? PG8_BF4(bh[g & 1][bj * 2 + n]) : bq[g & 1][bj * 2 + n];
                        const f32x4 v = acc[ai][bj][m][n] * scale + bv;
                        *(PG8_GAS u32x2_*)(gout16 + off + bj * HALF + n * 16) = (u32x2_){cvt_pk_bf16(v[0], v[1]), cvt_pk_bf16(v[2], v[3])};
                        sq += (v[0] * v[0] + v[1] * v[1]) + (v[2] * v[2] + v[3] * v[3]);
                        if (!second) { const f32x4 a = v * gw[bj][n]; int w8 = 0;       w8 = __builtin_amdgcn_cvt_pk_fp8_f32(a[0], a[1], w8, false); w8 = __builtin_amdgcn_cvt_pk_fp8_f32(a[2], a[3], w8, true);
                            *(PG8_GAS int*)(gan8 + off + bj * HALF + n * 16) = w8; } }
                sq = xrow_sum4(sq);
                if (fq == 0) gssp[(size_t)row * 32 + u.pnl * 4 + wc] = sq; }
            return;
        }
        if (u.tl() >= 0) {
            PG8_GAS float* pt = (PG8_GAS float*)out + (size_t)(u.tl() * u.ks() + u.kp()) * (BM * BM) + (size_t)(wr * 64 + fr) * BM + wc * 32 + 4 * fq;
#pragma unroll
            for (int ai = 0; ai < 2; ++ai)
#pragma unroll
                for (int m = 0; m < 4; ++m)
#pragma unroll
                    for (int bj = 0; bj < 2; ++bj)
#pragma unroll
                        for (int n = 0; n < 2; ++n) *(PG8_GAS f32x4*)(pt + (size_t)(ai * HALF + m * 16) * BM + bj * HALF + n * 16) = acc[ai][bj][m][n] * scale;
            return;
        }
        if (base && !out16) {
            typedef unsigned u32x2_ __attribute__((ext_vector_type(2)));
            const PG8_GAS bf16_t* gbase16 = (const PG8_GAS bf16_t*)base; PG8_GAS bf16_t* gout16 = (PG8_GAS bf16_t*)out; const int ld = ldc;
            u32x2_ bh[2][4];
            PG8_ER_LDH(0, bh[0]);
#pragma unroll
            for (int g = 0; g < 8; ++g) { const int ai = g >> 2, m = g & 3;
                if (g + 1 < 8) PG8_ER_LDH(g + 1, bh[(g + 1) & 1]);
                const size_t off = (size_t)(row0 + ai * HALF + m * 16) * ldc + col0;
#pragma unroll
                for (int bj = 0; bj < 2; ++bj)
#pragma unroll
                    for (int n = 0; n < 2; ++n) { const f32x4 v = acc[ai][bj][m][n] * scale + PG8_BF4(bh[g & 1][bj * 2 + n]);
                        *(PG8_GAS u32x2_*)(gout16 + off + bj * HALF + n * 16) = (u32x2_){cvt_pk_bf16(v[0], v[1]), cvt_pk_bf16(v[2], v[3])}; } }
            return;
        }
#pragma unroll
        for (int ai = 0; ai < 2; ++ai)
#pragma unroll
            for (int m = 0; m < 4; ++m) { const size_t off = (size_t)(row0 + ai * HALF + m * 16) * ldc + col0;
#pragma unroll
                for (int bj = 0; bj < 2; ++bj)
#pragma unroll
                    for (int n = 0; n < 2; ++n) { f32x4 v = acc[ai][bj][m][n] * scale;
                        if (out16) { typedef unsigned u32x2_ __attribute__((ext_vector_type(2))); *(PG8_GAS u32x2_*)((PG8_GAS bf16_t*)out16 + off + bj * HALF + n * 16) = (u32x2_){cvt_pk_bf16(v[0], v[1]), cvt_pk_bf16(v[2], v[3])}; }
                        else { if (base) v += *(const f32x4*)(base + off + bj * HALF + n * 16); *(f32x4*)(out + off + bj * HALF + n * 16) = v; } } }
    }
};

template <class Epi, class Sched, bool ALIGN_EPI = false, bool SP2 = false, bool FP8 = false>
__device__ __forceinline__ void gemm_phase(PG8_LAS unsigned char* lds, const Gemm g, const Sched& S, const Epi& E) {
    int tid_ = threadIdx.x; asm volatile("" : "+v"(tid_));
    const int tid = tid_, wid = __builtin_amdgcn_readfirstlane(tid >> 6), lane = tid & 63, wr = wid >> 2, wc = wid & 3, fr = lane & 15, fq = lane >> 4;
    const int K = g.K, nt = K / BK;
    unsigned voffA[2], voffB[2];
#pragma unroll
    for (int i = 0; i < 2; ++i) { int R, C; stage_rc(tid * 16 + i * 8192, R, C); const int Rb = Epi::PERM ? ((R & ~31) + perm32(R & 31)) : R;
        voffA[i] = (unsigned)(R * K + C) * 2u; voffB[i] = (unsigned)(Rb * K + C) * 2u; }
    const size_t kstep = (size_t)(BK * 2);
    const size_t hstep = (size_t)HALF * K * 2;
    const size_t tstep = 2 * hstep;
    const unsigned ldsw = (unsigned)wid * 1024u;
    const int aoff = lds_byte(wr * 64 + fr, fq * 8), boff = lds_byte(wc * 32 + fr, fq * 8);
#define PG8_SA(b, h) (((b) * 2 + (h)) * HTB)
#define PG8_SB(b, h) ((4 + (b) * 2 + (h)) * HTB)
#define PG8_STAGE(bufoff, gbase, voff) do { _Pragma("unroll") for (int _i = 0; _i < 2; ++_i) \
        __builtin_amdgcn_global_load_lds((const unsigned*)((const char*)(gbase) + (voff)[_i]), (PG8_LAS unsigned*)(lds + (bufoff) + ldsw + _i * 8192), 16, 0, 0); } while (0)
#define PG8_LDA(dst, b, h) do { _Pragma("unroll") for (int m = 0; m < 4; ++m) { dst[m].lo = *(const PG8_LAS bf16x8*)(lds + PG8_SA(b, h) + aoff + m * 2048); dst[m].hi = *(const PG8_LAS bf16x8*)(lds + PG8_SA(b, h) + aoff + m * 2048 + 1024); } } while (0)
#define PG8_LDB(dst, b, h) do { _Pragma("unroll") for (int n = 0; n < 2; ++n) { dst[n].lo = *(const PG8_LAS bf16x8*)(lds + PG8_SB(b, h) + boff + n * 2048); dst[n].hi = *(const PG8_LAS bf16x8*)(lds + PG8_SB(b, h) + boff + n * 2048 + 1024); } } while (0)
#define PG8_MMA(ai, bj, At, Bt) do { __builtin_amdgcn_s_setprio(1); _Pragma("unroll") for (int m = 0; m < 4; ++m) _Pragma("unroll") for (int n = 0; n < 2; ++n) { \
        if constexpr (FP8) { typedef int v8i_ __attribute__((ext_vector_type(8))); \
            asm volatile("v_mfma_scale_f32_16x16x128_f8f6f4 %0, %1, %2, %0, %3, %3 op_sel_hi:[0,0,0]" : "+v"(acc[ai][bj][m][n]) : "v"(__builtin_bit_cast(v8i_, Bt[n])), "v"(__builtin_bit_cast(v8i_, At[m])), "v"(sc1_)); } \
        else { acc[ai][bj][m][n] = __builtin_amdgcn_mfma_f32_16x16x32_bf16(Bt[n].lo, At[m].lo, acc[ai][bj][m][n], 0, 0, 0); acc[ai][bj][m][n] = __builtin_amdgcn_mfma_f32_16x16x32_bf16(Bt[n].hi, At[m].hi, acc[ai][bj][m][n], 0, 0, 0); } } \
        __builtin_amdgcn_s_setprio(0); } while (0)
#define PG8_WAIT_V(n) asm volatile("s_waitcnt vmcnt(" #n ")" ::: "memory")
#define PG8_WAIT_L(n) asm volatile("s_waitcnt lgkmcnt(" #n ")" ::: "memory")
#define PG8_BAR __builtin_amdgcn_s_barrier()
#define PG8_SCHED __builtin_amdgcn_sched_barrier(0)
    Unit cur, nxt; int ui = 0;
    if (!S.next(0, cur)) return;
    f32x4 acc[2][2][4][2];
#pragma unroll
    for (int a = 0; a < 2; ++a)
#pragma unroll
        for (int b = 0; b < 2; ++b)
#pragma unroll
            for (int m = 0; m < 4; ++m)
#pragma unroll
                for (int n = 0; n < 2; ++n) acc[a][b][m][n] = (f32x4){0.f, 0.f, 0.f, 0.f};
    typedef short s16x16 __attribute__((ext_vector_type(16)));
    s16x16 At[4], B0[2], B1[2];
    int sc1_ = 0x7f7f7f7f; asm volatile("" : "+v"(sc1_));
    const char* cA = (const char*)g.A + (size_t)cur.pm * tstep + (size_t)(cur.kp() * (nt / cur.ks())) * kstep; const char* cB = (const char*)g.Bt + (size_t)cur.pn * tstep + (size_t)(cur.kp() * (nt / cur.ks())) * kstep;
    S.a_ready(cur);
    if constexpr (SP2) {
        PG8_STAGE(PG8_SB(0, 0), cB, voffB); PG8_STAGE(PG8_SB(0, 1), cB + hstep, voffB); PG8_STAGE(PG8_SA(0, 0), cA, voffA); PG8_STAGE(PG8_SA(0, 1), cA + hstep, voffA);
        if (wr == 1) PG8_BAR;
        PG8_WAIT_V(2); PG8_BAR;
        PG8_STAGE(PG8_SB(1, 0), cB + kstep, voffB); PG8_STAGE(PG8_SA(1, 0), cA + kstep, voffA); PG8_STAGE(PG8_SB(1, 1), cB + hstep + kstep, voffB);
        PG8_WAIT_V(6); PG8_BAR;
    } else {
        PG8_STAGE(PG8_SB(0, 0), cB, voffB); PG8_STAGE(PG8_SA(0, 0), cA, voffA); PG8_STAGE(PG8_SB(0, 1), cB + hstep, voffB); PG8_STAGE(PG8_SA(0, 1), cA + hstep, voffA);
        if (wr == 1) PG8_BAR;
        PG8_WAIT_V(4); PG8_BAR;
        PG8_STAGE(PG8_SB(1, 0), cB + kstep, voffB); PG8_STAGE(PG8_SA(1, 0), cA + kstep, voffA); PG8_STAGE(PG8_SB(1, 1), cB + hstep + kstep, voffB);
        PG8_WAIT_V(6); PG8_BAR;
    }
    for (;;) {
        const bool has_next = S.next(ui + 1, nxt);
        const char* nA = has_next ? (const char*)g.A + (size_t)nxt.pm * tstep + (size_t)(nxt.kp() * (nt / nxt.ks())) * kstep : cA; const char* nB = has_next ? (const char*)g.Bt + (size_t)nxt.pn * tstep + (size_t)(nxt.kp() * (nt / nxt.ks())) * kstep : cB;
        const int ntc = nt / cur.ks();
        for (int t = 0; t < ntc; t += 2) {
            const bool last = (t == ntc - 2);
            const char* a1 = cA + (size_t)(t + 1) * kstep;
            const char* a2 = last ? nA : cA + (size_t)(t + 2) * kstep; const char* b2 = last ? nB : cB + (size_t)(t + 2) * kstep;
            const char* a3 = a2 + kstep; const char* b3 = b2 + kstep;
            if (last && has_next) S.a_ready(nxt);
            if constexpr (SP2) {
            PG8_LDB(B0, 0, 0); PG8_LDB(B1, 0, 1); PG8_SCHED; PG8_LDA(At, 0, 0); PG8_STAGE(PG8_SA(1, 1), a1 + hstep, voffA);
            PG8_WAIT_V(8); PG8_WAIT_L(0); PG8_BAR; PG8_MMA(0, 0, At, B0); PG8_MMA(0, 1, At, B1); PG8_BAR; PG8_SCHED;
            PG8_LDA(At, 0, 1); PG8_STAGE(PG8_SB(0, 0), b2, voffB); PG8_STAGE(PG8_SB(0, 1), b2 + hstep, voffB); PG8_STAGE(PG8_SA(0, 0), a2, voffA);
            PG8_WAIT_V(8); PG8_WAIT_L(0); PG8_BAR; PG8_MMA(1, 0, At, B0); PG8_MMA(1, 1, At, B1); PG8_BAR; PG8_SCHED;
            PG8_LDB(B0, 1, 0); PG8_LDB(B1, 1, 1); PG8_SCHED; PG8_LDA(At, 1, 0); PG8_STAGE(PG8_SA(0, 1), a2 + hstep, voffA);
            PG8_WAIT_V(8); PG8_WAIT_L(0); PG8_BAR; PG8_MMA(0, 0, At, B0); PG8_MMA(0, 1, At, B1); PG8_BAR; PG8_SCHED;
            PG8_LDA(At, 1, 1); PG8_STAGE(PG8_SB(1, 0), b3, voffB); PG8_STAGE(PG8_SB(1, 1), b3 + hstep, voffB); PG8_STAGE(PG8_SA(1, 0), a3, voffA);
            PG8_WAIT_V(8); PG8_WAIT_L(0); PG8_BAR; PG8_MMA(1, 0, At, B0); PG8_MMA(1, 1, At, B1); PG8_BAR; PG8_SCHED;
            } else {
            PG8_LDB(B0, 0, 0); PG8_SCHED; PG8_LDA(At, 0, 0); PG8_STAGE(PG8_SA(1, 1), a1 + hstep, voffA);
            PG8_WAIT_L(8); PG8_BAR; PG8_WAIT_L(0); PG8_MMA(0, 0, At, B0); PG8_BAR; PG8_SCHED;
            PG8_LDB(B1, 0, 1); PG8_STAGE(PG8_SB(0, 0), b2, voffB);
            PG8_BAR; PG8_WAIT_L(0); PG8_MMA(0, 1, At, B1); PG8_BAR;
            PG8_LDA(At, 0, 1); PG8_STAGE(PG8_SA(0, 0), a2, voffA);
            PG8_BAR; PG8_WAIT_L(0); PG8_MMA(1, 0, At, B0); PG8_BAR; PG8_SCHED;
            PG8_STAGE(PG8_SB(0, 1), b2 + hstep, voffB);
            PG8_WAIT_V(6); PG8_BAR; PG8_MMA(1, 1, At, B1); PG8_BAR;
            PG8_LDB(B0, 1, 0); PG8_SCHED; PG8_LDA(At, 1, 0); PG8_STAGE(PG8_SA(0, 1), a2 + hstep, voffA);
            PG8_WAIT_L(8); PG8_BAR; PG8_WAIT_L(0); PG8_MMA(0, 0, At, B0); PG8_BAR; PG8_SCHED;
            PG8_LDB(B1, 1, 1); PG8_STAGE(PG8_SB(1, 0), b3, voffB);
            PG8_BAR; PG8_WAIT_L(0); PG8_MMA(0, 1, At, B1); PG8_BAR;
            PG8_LDA(At, 1, 1); PG8_STAGE(PG8_SA(1, 0), a3, voffA);
            PG8_BAR; PG8_WAIT_L(0); PG8_MMA(1, 0, At, B0); PG8_BAR; PG8_SCHED;
            PG8_STAGE(PG8_SB(1, 1), b3 + hstep, voffB);
            PG8_WAIT_V(6); PG8_BAR; PG8_MMA(1, 1, At, B1); PG8_BAR;
            }
        }
        if constexpr (ALIGN_EPI) { if (wr == 0) PG8_BAR; }
        if constexpr (FP8) asm volatile("s_nop 15\n\ts_nop 15" ::: "memory");
        if constexpr (!Epi::AFTER_DRAIN) { E(acc, cur, wr, wc, fr, fq); S.done(cur); }
        if (!has_next) break;
#pragma unroll
        for (int a = 0; a < 2; ++a)
#pragma unroll
            for (int b = 0; b < 2; ++b)
#pragma unroll
                for (int m = 0; m < 4; ++m)
#pragma unroll
                    for (int n = 0; n < 2; ++n) acc[a][b][m][n] = (f32x4){0.f, 0.f, 0.f, 0.f};
        cur = nxt; cA = nA; cB = nB; ++ui;
        if constexpr (ALIGN_EPI) { if (wr == 1) PG8_BAR; }
    }
    PG8_WAIT_V(0);
    if constexpr (!ALIGN_EPI) { if (wr == 0) PG8_BAR; }
    PG8_BAR;
#undef PG8_SA
#undef PG8_SB
#undef PG8_STAGE
#undef PG8_LDA
#undef PG8_LDB
#undef PG8_MMA
#undef PG8_WAIT_V
#undef PG8_WAIT_L
#undef PG8_BAR
#undef PG8_SCHED
}
}


#define GAS __attribute__((address_space(1)))
#define LAS __attribute__((address_space(3)))
typedef unsigned short bf16;
typedef unsigned v4u __attribute__((ext_vector_type(4)));
typedef unsigned v2u __attribute__((ext_vector_type(2)));
typedef float f32x4 __attribute__((ext_vector_type(4)));
typedef float f32x2 __attribute__((ext_vector_type(2)));
typedef short bf16x8 __attribute__((ext_vector_type(8)));
typedef short s16x4 __attribute__((ext_vector_type(4)));
#define LDS_WAIT() asm volatile("s_waitcnt lgkmcnt(0)" ::: "memory")
__device__ __forceinline__ unsigned f2bf(float f) { unsigned u = __builtin_bit_cast(unsigned, f); return (u + 0x7fffu + ((u >> 16) & 1u)) >> 16; }
__device__ __forceinline__ unsigned pk2(float lo, float hi) { return f2bf(lo) | (f2bf(hi) << 16); }
__device__ __forceinline__ float bf2f(unsigned b) { return __builtin_bit_cast(float, b << 16); }
__device__ __forceinline__ float bflo(unsigned w) { return __builtin_bit_cast(float, w << 16); }
__device__ __forceinline__ float bfhi(unsigned w) { return __builtin_bit_cast(float, w & 0xffff0000u); }
__device__ __forceinline__ float wave_sum(float v) {
    int x = __builtin_bit_cast(int, v);
#define WS_DPP_ADD(ctrl, rmask) x = __builtin_bit_cast(int, __builtin_bit_cast(float, x) + __builtin_bit_cast(float, __builtin_amdgcn_update_dpp(0, x, (ctrl), (rmask), 0xF, false)))
    WS_DPP_ADD(0x121, 0xF); WS_DPP_ADD(0x122, 0xF); WS_DPP_ADD(0x124, 0xF); WS_DPP_ADD(0x128, 0xF);
    WS_DPP_ADD(0x142, 0xA);
    WS_DPP_ADD(0x143, 0xC);
#undef WS_DPP_ADD
    return __builtin_bit_cast(float, __builtin_amdgcn_readlane(x, 63));
}
__device__ __forceinline__ int wave_sum_i(int v) {
#pragma unroll
    for (int o = 1; o < 64; o <<= 1) v += __shfl_xor(v, o);
    return v;
}
__device__ __forceinline__ float xrow_sum(float v) {
    { const unsigned x = __builtin_bit_cast(unsigned, v); const auto r = __builtin_amdgcn_permlane32_swap(x, x, false, false); v = __builtin_bit_cast(float, (unsigned)r[0]) + __builtin_bit_cast(float, (unsigned)r[1]); }
    { const unsigned x = __builtin_bit_cast(unsigned, v); const auto r = __builtin_amdgcn_permlane16_swap(x, x, false, false); v = __builtin_bit_cast(float, (unsigned)r[0]) + __builtin_bit_cast(float, (unsigned)r[1]); }
    return v;
}
__device__ __forceinline__ float xrow_max(float v) {
    { const unsigned x = __builtin_bit_cast(unsigned, v); const auto r = __builtin_amdgcn_permlane32_swap(x, x, false, false); v = fmaxf(__builtin_bit_cast(float, (unsigned)r[0]), __builtin_bit_cast(float, (unsigned)r[1])); }
    { const unsigned x = __builtin_bit_cast(unsigned, v); const auto r = __builtin_amdgcn_permlane16_swap(x, x, false, false); v = fmaxf(__builtin_bit_cast(float, (unsigned)r[0]), __builtin_bit_cast(float, (unsigned)r[1])); }
    return v;
}
__device__ __forceinline__ float row16_sum(float v) {
    int x = __builtin_bit_cast(int, v);
#define R16_ADD(ctrl) x = __builtin_bit_cast(int, __builtin_bit_cast(float, x) + __builtin_bit_cast(float, __builtin_amdgcn_update_dpp(0, x, (ctrl), 0xF, 0xF, false)))
    R16_ADD(0x121); R16_ADD(0x122); R16_ADD(0x124); R16_ADD(0x128);
#undef R16_ADD
    return __builtin_bit_cast(float, x);
}
__device__ __forceinline__ float sigmoidf_(float x) { return __builtin_amdgcn_rcpf(1.0f + __builtin_amdgcn_exp2f(-1.4426950408889634f * x)); }
__device__ __forceinline__ float siluf_(float x) { return x * sigmoidf_(x); }
__device__ __forceinline__ float fexp(float x) { return __builtin_amdgcn_exp2f(1.4426950408889634f * x); }

#define XB_TMO      128
#define XB_XCNT(j)  (256  + 64 * (j))
#define XB_XSUB(j)  (1280 + 64 * (j))
#define XB_XGEN(j)  (2304 + 64 * (j))
#define XB_TOP      3328
#define XB_TOPGEN   3392
#define XCD_BAR_WORDS 3456
#define XB_SPIN_CAP (1u << 18)
__device__ __forceinline__ unsigned xb_ld(unsigned* p)              { return __hip_atomic_load(p, __ATOMIC_RELAXED, __HIP_MEMORY_SCOPE_AGENT); }
__device__ __forceinline__ unsigned xb_add(unsigned* p, unsigned v) { return __hip_atomic_fetch_add(p, v, __ATOMIC_RELAXED, __HIP_MEMORY_SCOPE_AGENT); }
__device__ __forceinline__ unsigned xb_xcc_id() { return (unsigned)__builtin_amdgcn_s_getreg((3 << 11) | 20) & 0xFu; }
#define XB_SPIN(cond, bar) do { unsigned _sp = 0; while (cond) { __builtin_amdgcn_s_sleep(1); \
    if ((++_sp & 255u) == 0u) { if (xb_ld(&(bar)[XB_TMO])) break; if (_sp > XB_SPIN_CAP) { atomicAdd(&(bar)[XB_TMO], 1u); break; } } } } while (0)
struct XcdBarrier { unsigned* bar; unsigned x; volatile LAS unsigned* st; };
__device__ __forceinline__ XcdBarrier xcd_barrier_post(unsigned* bar, volatile LAS unsigned* st) {
    XcdBarrier b; b.bar = bar; b.x = xb_xcc_id(); b.st = st;
    if (threadIdx.x == 0) (void)xb_add(&bar[XB_XCNT(b.x)], 1u);
    return b;
}
__device__ __forceinline__ void xcd_barrier_complete(unsigned* bar, unsigned x, unsigned& nloc, unsigned& nx) {
    const unsigned G = gridDim.x * gridDim.y * gridDim.z;
    unsigned sum, cnt, mine, sp = 0u;
    for (;;) {
        sum = 0u; cnt = 0u; mine = 0u;
#pragma unroll
        for (unsigned j = 0; j < 16; ++j) { const unsigned c = xb_ld(&bar[XB_XCNT(j)]); sum += c; cnt += (c > 0u) ? 1u : 0u; mine = (j == x) ? c : mine; }
        if (sum == G) break;
        __builtin_amdgcn_s_sleep(1);
        if ((++sp & 255u) == 0u) { if (xb_ld(&bar[XB_TMO])) break; if (sp > XB_SPIN_CAP) { atomicAdd(&bar[XB_TMO], 1u); break; } }
    }
    nloc = mine > 0u ? mine : 1u; nx = cnt > 0u ? cnt : 1u;
}
__device__ __forceinline__ void xcd_barrier(const XcdBarrier& b) {
    asm volatile("s_waitcnt vmcnt(0)" ::: "memory");
    __syncthreads();
    if (threadIdx.x == 0) {
        unsigned* bar = b.bar;
        __builtin_amdgcn_s_waitcnt(0);
        unsigned nloc = b.st[0], nx = b.st[1];
        if (nloc == 0u) { xcd_barrier_complete(bar, b.x, nloc, nx); b.st[0] = nloc; b.st[1] = nx; }
        const unsigned old = xb_add(&bar[XB_XSUB(b.x)], 1u);
        const unsigned gen = old / nloc;
        if (old + 1u == (gen + 1u) * nloc) {
            __builtin_amdgcn_fence(__ATOMIC_RELEASE, "agent");
            asm volatile("s_waitcnt vmcnt(0)" ::: "memory");
            const unsigned og = xb_add(&bar[XB_TOP], 1u);
            const unsigned tg = og / nx;
            if (og + 1u == (tg + 1u) * nx) xb_add(&bar[XB_TOPGEN], 1u);
            else XB_SPIN(xb_ld(&bar[XB_TOPGEN]) == tg, bar);
            __builtin_amdgcn_fence(__ATOMIC_ACQUIRE, "agent");
            xb_add(&bar[XB_XGEN(b.x)], 1u);
            asm volatile("s_waitcnt vmcnt(0)" ::: "memory");
        } else {
            XB_SPIN(xb_ld(&bar[XB_XGEN(b.x)]) == gen, bar);
            __builtin_amdgcn_fence(__ATOMIC_ACQUIRE, "agent");
            asm volatile("s_waitcnt vmcnt(0)" ::: "memory");
        }
    }
    __syncthreads();
}

static __device__ __noinline__ void grid_barrier(LAS unsigned char* lds) {
    volatile LAS unsigned* MISC = (volatile LAS unsigned*)(lds + 131072);
    volatile LAS unsigned* ap = (volatile LAS unsigned*)(lds + 131072 + 1024) + 2 * 24; unsigned lo = ap[0], hi = ap[1];
    lo = __builtin_amdgcn_readfirstlane(lo); hi = __builtin_amdgcn_readfirstlane(hi);
    XcdBarrier b; b.bar = (unsigned*)(((unsigned long long)hi << 32) | lo) + 4096; b.x = __builtin_amdgcn_readfirstlane(MISC[2]); b.st = MISC;
    xcd_barrier(b);
}
template <int K>
__device__ __forceinline__ f32x4 mma_lds(f32x4 acc, const LAS unsigned char* A, int pa, const LAS unsigned char* Bt, int pb, int lane) {
    const int i = lane & 15, g = lane >> 4;
#pragma unroll
    for (int k = 0; k < K; k += 32) {
        const bf16x8 a = *(const LAS bf16x8*)(A + i * pa + (k + 8 * g) * 2);
        const bf16x8 b = *(const LAS bf16x8*)(Bt + i * pb + (k + 8 * g) * 2);
        acc = __builtin_amdgcn_mfma_f32_16x16x32_bf16(a, b, acc, 0, 0, 0);
    }
    return acc;
}

struct Args { const float* in[23]; float* out; unsigned char* ws; int ph_lo, ph_hi; };
enum { I_X = 0, I_NMIX, I_WIN, I_SCW, I_SCB, I_SDTB, I_SALOG, I_SD, I_SNW, I_CCW, I_CCB, I_CLW, I_CLB, I_WOUT, I_NFFN, I_FG, I_FU, I_FD, I_RT, I_MG, I_MU, I_MD, I_NFIN };

constexpr int ARGS_OFF = 131072 + 1024;
__device__ __forceinline__ const void* ldarg(LAS unsigned char* lds, int k) {
    volatile LAS unsigned* p = (volatile LAS unsigned*)(lds + ARGS_OFF) + 2 * k; unsigned lo = p[0], hi = p[1];
    lo = __builtin_amdgcn_readfirstlane(lo); hi = __builtin_amdgcn_readfirstlane(hi); return (const void*)(((unsigned long long)hi << 32) | lo); }
__device__ __forceinline__ const void* ldarg_g(LAS unsigned char* lds, int k) {
    volatile LAS unsigned* p = (volatile LAS unsigned*)(lds + ARGS_OFF) + 2 * k; unsigned lo = p[0], hi = p[1];
    lo = __builtin_amdgcn_readfirstlane(lo); hi = __builtin_amdgcn_readfirstlane(hi);
    const GAS char* gp = (const GAS char*)(((unsigned long long)hi << 32) | lo); return (const void*)gp; }
#define ARGWS_G() ((unsigned char*)ldarg_g(lds, 24))
#define ARGF_G(k) ((const float*)ldarg_g(lds, (k)))
#define ARGF(k) ((const float*)ldarg(lds, (k)))
#define ARGWS() ((unsigned char*)ldarg(lds, 24))
#define ARGOUT() ((float*)ldarg(lds, 23))
struct CvDesc { const float* src; unsigned char* dst; unsigned ld, pitchB; int f8; const float* gk; };
__device__ __forceinline__ void cv_load(const CvDesc& d, f32x4 (&v)[16], int lane) {
    const int kr = lane >> 4, c4 = lane & 15;
#pragma unroll
    for (int i = 0; i < 16; ++i) v[i] = __builtin_nontemporal_load((const f32x4*)(d.src + (size_t)(4 * i + kr) * d.ld + 4 * c4));
}
__device__ __forceinline__ void cv_store(const CvDesc& d, const f32x4 (&v)[16], LAS unsigned char* scr, int lane) {
    const int kr = lane >> 4, c4 = lane & 15;
    const float wsc = d.f8 ? 128.0f : 1.0f;
    if (d.gk) {
        float gr[16];
#pragma unroll
        for (int i = 0; i < 16; ++i) gr[i] = d.gk[4 * i + kr];
#pragma unroll
        for (int i = 0; i < 16; ++i) { const float ws2 = wsc * gr[i]; v2u w; w.x = pg8::cvt_pk_bf16(v[i][0] * ws2, v[i][1] * ws2); w.y = pg8::cvt_pk_bf16(v[i][2] * ws2, v[i][3] * ws2); *(LAS v2u*)(scr + (4 * i + kr) * 136 + 8 * c4) = w; }
    } else {
#pragma unroll
    for (int i = 0; i < 16; ++i) { v2u w; w.x = pg8::cvt_pk_bf16(v[i][0] * wsc, v[i][1] * wsc); w.y = pg8::cvt_pk_bf16(v[i][2] * wsc, v[i][3] * wsc); *(LAS v2u*)(scr + (4 * i + kr) * 136 + 8 * c4) = w; }
    }
    LDS_WAIT(); asm volatile("" ::: "memory");
    const int g = lane >> 4, i16 = lane & 15, q = i16 >> 2, p = i16 & 3;
    if (d.f8) {
#pragma unroll
        for (int j = 0; j < 4; ++j) {
            const int nb = 16 * j;
            int w[4];
#pragma unroll
            for (int r = 0; r < 4; ++r) {
                const s16x4 a = __builtin_amdgcn_ds_read_tr16_b64_v4i16((LAS s16x4*)(scr + (16 * g + 4 * r + q) * 136 + (nb + 4 * p) * 2));
                int t = 0; t = __builtin_amdgcn_cvt_pk_fp8_f32(bf2f((unsigned short)a[0]), bf2f((unsigned short)a[1]), t, false); t = __builtin_amdgcn_cvt_pk_fp8_f32(bf2f((unsigned short)a[2]), bf2f((unsigned short)a[3]), t, true);
                w[r] = t;
            }
            typedef int i32x4 __attribute__((ext_vector_type(4)));
            __builtin_nontemporal_store((i32x4){w[0], w[1], w[2], w[3]}, (i32x4*)(d.dst + (size_t)(nb + i16) * d.pitchB + 16 * g));
        }
        LDS_WAIT(); asm volatile("" ::: "memory");
        return;
    }
#pragma unroll
    for (int j = 0; j < 8; ++j) {
        const int nb = 16 * (j & 3), kc = (j >> 2) * 4 + g;
        const LAS unsigned char* ad = scr + (8 * kc + q) * 136 + (nb + 4 * p) * 2;
        const s16x4 a0 = __builtin_amdgcn_ds_read_tr16_b64_v4i16((LAS s16x4*)ad);
        const s16x4 a1 = __builtin_amdgcn_ds_read_tr16_b64_v4i16((LAS s16x4*)(ad + 4 * 136));
        unsigned char* rowp = d.dst + (size_t)(nb + i16) * d.pitchB;
        { const bf16x8 o = {a0[0], a0[1], a0[2], a0[3], a1[0], a1[1], a1[2], a1[3]};
            *(bf16x8*)(rowp + 16 * kc) = o; }
    }
    LDS_WAIT(); asm volatile("" ::: "memory");
}
constexpr int IT_IN = 32 * (NP / 64), IT_OUT = 32 * 32, IT_GU = 32 * 224, IT_DN = 112 * 32, IT_FF = IT_GU + IT_DN;
constexpr int IT_EARLY = 2 * IT_IN + 2 * IT_OUT + IT_FF;
constexpr int IT_TOTAL = IT_EARLY + 8 * IT_FF;
__device__ __forceinline__ CvDesc cv_decode(LAS unsigned char* lds, int it) {
    unsigned char* ws = ARGWS_G(); CvDesc d; d.gk = nullptr; int r = it;
    if (r < 2 * IT_IN) {
        const int l = r / IT_IN; r -= l * IT_IN; const int kb = r / (NP / 64), gi = r % (NP / 64), phys = 64 * gi; int scol;
        if (phys < 2048) { const int part = phys >> 10, within = phys & 1023, pn = within >> 8, bj = (within >> 7) & 1, o = within & 127; scol = part * 1024 + (2 * pn + (o >> 6)) * 128 + 64 * bj + (o & 63); }
        else if (phys < 4608) scol = phys; else scol = phys + 8;
        d.src = ARGF_G(I_WIN) + (size_t)l * DM * IN_DIM + (size_t)(64 * kb) * IN_DIM + scol; d.ld = IN_DIM; d.pitchB = DM * 2; d.f8 = 0;
        d.dst = ws + WS_WIN + ((size_t)l * NP * DM + (size_t)phys * DM + 64 * kb) * 2;
        if (l == 1) d.gk = ARGF_G(I_NMIX) + DM + 64 * kb;
        return d;
    }
    r -= 2 * IT_IN;
    if (r < 2 * IT_OUT) {
        const int l = r / IT_OUT; r -= l * IT_OUT; const int kb = r / 32, gi = r % 32;
        d.src = ARGF_G(I_WOUT) + (size_t)l * DM * DM + (size_t)(64 * kb) * DM + 64 * gi; d.ld = DM; d.pitchB = DM * 2; d.f8 = 0;
        d.dst = ws + WS_WOUT + ((size_t)l * DM * DM + (size_t)(64 * gi) * DM + 64 * kb) * 2; return d;
    }
    r -= 2 * IT_OUT;
    const int e9 = r / IT_FF; r -= e9 * IT_FF;
    if (r < IT_GU) {
        int kb = r / 224, gi = r % 224; if (e9) { kb = 2 * (r / 448) + (r & 1); gi = (r % 448) >> 1; }
        const int phys = 64 * gi, pn = phys >> 8, bj = (phys >> 7) & 1, o = phys & 127, ff = 128 * pn + o;
        const float* src = e9 == 0 ? ARGF_G(bj ? I_FU : I_FG) : (ARGF_G(bj ? I_MU : I_MG) + (size_t)(e9 - 1) * DM * DFF);
        d.src = src + (size_t)(64 * kb) * DFF + ff; d.ld = DFF;
        if (e9 == 0) { d.f8 = 1; d.pitchB = DM; d.dst = ws + WS_WGU + (size_t)phys * DM + 64 * kb; }
        else { d.f8 = 1; d.pitchB = DM; d.dst = ws + WS_WGU8 + (size_t)(e9 - 1) * 2 * DFF * DM + (size_t)phys * DM + 64 * kb; }
    } else {
        r -= IT_GU; int kb = r / 32, gi = r % 32; if (e9) { kb = 2 * (r / 64) + (r & 1); gi = (r % 64) >> 1; }
        const float* src = e9 == 0 ? ARGF_G(I_FD) : (ARGF_G(I_MD) + (size_t)(e9 - 1) * DFF * DM);
        d.src = src + (size_t)(64 * kb) * DM + 64 * gi; d.ld = DM;
        if (e9 == 0) { d.f8 = 0; d.pitchB = DFF * 2; d.dst = ws + WS_WDN + ((size_t)(64 * gi) * DFF + 64 * kb) * 2; }
        else { d.f8 = 1; d.pitchB = DFF; d.dst = ws + WS_WDN8 + (size_t)(e9 - 1) * DM * DFF + (size_t)(64 * gi) * DFF + 64 * kb; }
    }
    return d;
}
__device__ __forceinline__ void cv_run(LAS unsigned char* lds, LAS unsigned char* scr, int lane, int it0, int stride, int it_end) {
    asm volatile("" : "+v"(lane));
#pragma unroll 1
    for (int it = it0; it < it_end; it += stride) {
        const CvDesc da = cv_decode(lds, it); f32x4 va[16];
        cv_load(da, va, lane);
        cv_store(da, va, scr, lane);
    }
}
__device__ __forceinline__ void p0_prologue(LAS unsigned char* lds, int tid, int lane, int wave, int vcu, int G) {
    LAS unsigned char* scr = lds + wave * 16384;
    const int gw = vcu * NWAVES + wave, NGW = G * NWAVES;
    unsigned char* ws = ARGWS();
    cv_run(lds, scr, lane, gw, NGW, IT_IN);
    if (vcu == 0) { const float* nf = ARGF(I_NFFN); const float* nm = ARGF(I_NMIX) + DM; float* nwc = (float*)(ws + WS_SMALL + SM_NWC);
        for (int k = tid; k < DM; k += 512) { nwc[k] = nf[k]; nwc[DM + k] = nm[k]; } if (tid < 8) nwc[2 * DM + tid] = ARGF(I_SDTB)[8 + tid]; }
    if (vcu == 1 % G) {
        bf16* dtt = (bf16*)(ws + WS_WIN) + (size_t)2 * NP * DM; const float* wi = ARGF(I_WIN) + (size_t)DM * IN_DIM + 4608;
        for (int k = tid; k < DM; k += 512) { const float gk_ = ARGF(I_NMIX)[DM + k];
            const f32x4 a = *(const f32x4*)(wi + (size_t)k * IN_DIM) * gk_, b = *(const f32x4*)(wi + (size_t)k * IN_DIM + 4) * gk_;
            dtt[0 * DM + k] = (bf16)f2bf(a[0]); dtt[1 * DM + k] = (bf16)f2bf(a[1]); dtt[2 * DM + k] = (bf16)f2bf(a[2]); dtt[3 * DM + k] = (bf16)f2bf(a[3]);
            dtt[4 * DM + k] = (bf16)f2bf(b[0]); dtt[5 * DM + k] = (bf16)f2bf(b[1]); dtt[6 * DM + k] = (bf16)f2bf(b[2]); dtt[7 * DM + k] = (bf16)f2bf(b[3]); }
        v4u* z = (v4u*)(dtt + 8 * DM); const v4u zero = {0u, 0u, 0u, 0u};
        for (int q = tid; q < 248 * DM * 2 / 16; q += 512) z[q] = zero;
    }
    float* rope = (float*)(ws + WS_ROPE);
    for (int idx = (vcu * NWAVES + wave) * 64 + lane; idx < SEQ * 64; idx += NGW * 64) {
        const int pos = idx >> 6, i = idx & 63;
        const float inv = __builtin_amdgcn_exp2f(-(float)(2 * i) * (13.287712379549449f / 128.0f));
        const float ang = (float)pos * inv;
        const float t = ang * 0.15915494309189535f, fr = t - floorf(t);
        rope[2 * idx] = __builtin_amdgcn_cosf(fr); rope[2 * idx + 1] = __builtin_amdgcn_sinf(fr);
    }
}

template <int MODE>
static __device__ __noinline__ void norm_phase(LAS unsigned char* lds, int tid, int lane, int wave, int vcu, int G,
        const float* __restrict__ hin, const float* __restrict__ nw, bf16* __restrict__ hn, const float* __restrict__ wsm, size_t ldsm,
        const float* __restrict__ bias8, float* __restrict__ dt_out, int* __restrict__ tok_e, f32x2* __restrict__ tok_g, int* __restrict__ wcnt, int* __restrict__ bcnt) {
    const GAS float* hin_g = (const GAS float*)hin; const GAS float* nw_g = (const GAS float*)nw; GAS unsigned char* hn_g = (GAS unsigned char*)hn;
    GAS float* dt_g = (GAS float*)dt_out; GAS int* toke_g = (GAS int*)tok_e; GAS f32x2* tokg_g = (GAS f32x2*)tok_g;
    LAS f32x4* wlA = (LAS f32x4*)lds;
    LAS f32x4* wlB = (LAS f32x4*)(lds + 32768);
    LAS int* lcnt = (LAS int*)(lds + 65536);
    if (MODE != 2) for (int k = tid; k < DM; k += 512) { const f32x4 va = *(const f32x4*)(wsm + (size_t)k * ldsm), vb = *(const f32x4*)(wsm + (size_t)k * ldsm + 4);
        const int j = k >> 8, ln = (k & 255) >> 2, e = k & 3, slot = (j * 4 + e) * 64 + ln; wlA[slot] = va; wlB[slot] = vb; }
    if (MODE == 1 && tid < 8) lcnt[tid] = 0;
    LAS f32x4* wlG = (LAS f32x4*)(lds + 65536 + 256);
    wlG[tid] = *(const GAS f32x4*)(nw_g + 4 * tid);
    __syncthreads();
    const int NGW = G * NWAVES, gw = vcu * NWAVES + wave, RPW = (M + NGW - 1) / NGW;
    int mycnt = 0;
    f32x4 xn[8]; v2u xh[8];
    const GAS bf16* hin16 = (const GAS bf16*)hin_g;
    { const int r0 = min(gw * RPW, M - 1);
#pragma unroll
      for (int j = 0; j < 8; ++j) { if (MODE == 1) xh[j] = *(const GAS v2u*)(hin16 + (size_t)r0 * DM + 4 * lane + 256 * j); else xn[j] = *(const GAS f32x4*)(hin_g + (size_t)r0 * DM + 4 * lane + 256 * j); } }
    for (int i = 0; i < RPW; ++i) {
        const int row = gw * RPW + i; if (row >= M) break;
        f32x4 x[8]; float ss = 0.f;
#pragma unroll
        for (int j = 0; j < 8; ++j) { x[j] = MODE == 1 ? (f32x4){bflo(xh[j].x), bfhi(xh[j].x), bflo(xh[j].y), bfhi(xh[j].y)} : xn[j]; ss += (x[j][0] * x[j][0] + x[j][1] * x[j][1]) + (x[j][2] * x[j][2] + x[j][3] * x[j][3]); }
        { const int rn = min(row + 1, M - 1);
#pragma unroll
          for (int j = 0; j < 8; ++j) { if (MODE == 1) xh[j] = *(const GAS v2u*)(hin16 + (size_t)rn * DM + 4 * lane + 256 * j); else xn[j] = *(const GAS f32x4*)(hin_g + (size_t)rn * DM + 4 * lane + 256 * j); } }
        ss = wave_sum(ss);
        const float rstd = 1.0f / sqrtf(ss * (1.0f / DM) + EPS);
        f32x4 accA = {0.f, 0.f, 0.f, 0.f}, accB = {0.f, 0.f, 0.f, 0.f};
#pragma unroll
        for (int j = 0; j < 8; ++j) {
            const f32x4 y = x[j] * rstd * wlG[j * 64 + lane];
            if (MODE == 1) { int w8 = 0; w8 = __builtin_amdgcn_cvt_pk_fp8_f32(y[0], y[1], w8, false); w8 = __builtin_amdgcn_cvt_pk_fp8_f32(y[2], y[3], w8, true);
                *(GAS int*)(hn_g + (size_t)row * DM + 4 * lane + 256 * j) = w8; }
            else { v2u o; o.x = pk2(y[0], y[1]); o.y = pk2(y[2], y[3]);
            *(GAS v2u*)(hn_g + ((size_t)row * DM + 4 * lane + 256 * j) * 2) = o; }
            if (MODE != 2) {
#pragma unroll
            for (int e = 0; e < 4; ++e) { const f32x4 wa = wlA[(j * 4 + e) * 64 + lane], wb = wlB[(j * 4 + e) * 64 + lane]; accA += y[e] * wa; accB += y[e] * wb; }
            }
        }
        if (MODE == 2) continue;
        float acc[8];
#pragma unroll
        for (int c = 0; c < 4; ++c) { acc[c] = wave_sum(accA[c]); acc[4 + c] = wave_sum(accB[c]); }
        if (MODE == 0) {
            float v = acc[0];
#pragma unroll
            for (int c = 1; c < 8; ++c) v = (lane == c) ? acc[c] : v;
            if (lane < 8) { const float xx = v + bias8[lane]; dt_g[(size_t)row * 8 + lane] = fmaxf(xx, 0.f) + log1pf(expf(-fabsf(xx))); }
        } else {
            float v0 = acc[0]; int i0 = 0;
#pragma unroll
            for (int c = 1; c < 8; ++c) if (acc[c] > v0) { v0 = acc[c]; i0 = c; }
            float v1 = -INFINITY; int i1 = 0;
#pragma unroll
            for (int c = 0; c < 8; ++c) if (c != i0 && acc[c] > v1) { v1 = acc[c]; i1 = c; }
            const float ex = expf(v1 - v0), g0 = 1.0f / (1.0f + ex), g1 = ex * g0;
            if (lane == 0) { toke_g[row] = i0 | (i1 << 8); tokg_g[row] = (f32x2){g0, g1}; }
            if (lane == i0 || lane == i1) ++mycnt;
        }
    }
    if (MODE == 1) {
        if (lane < 8) { wcnt[gw * 8 + lane] = mycnt; __hip_atomic_fetch_add(lcnt + lane, mycnt, __ATOMIC_RELAXED, __HIP_MEMORY_SCOPE_WORKGROUP); }
        __syncthreads();
        if (tid < 8) bcnt[vcu * 8 + tid] = lcnt[tid];
    }
    __syncthreads();
}

static __device__ __noinline__ void gather_phase(LAS unsigned char* lds, int tid, int lane, int wave, int vcu, int G) {
    unsigned char* ws = ARGWS_G();
    LAS int* tt = (LAS int*)lds;
    const int* bcnt = (const int*)(ws + WS_SMALL + SM_BCNT); const int* wcnt = (const int*)(ws + WS_SMALL + SM_WCNT);
    const int* tok_e = (const int*)(ws + WS_SMALL + SM_TOKE); int* pos = (int*)(ws + WS_SMALL + SM_POS);
    const unsigned char* hn = ws + WS_HN8; unsigned char* xp = ws + WS_XP8;
    { int st = 0, sp = 0; for (int b2 = lane; b2 < G; b2 += 64) { const int v = bcnt[b2 * 8 + wave]; st += v; if (b2 < vcu) sp += v; }
      st = wave_sum_i(st); sp = wave_sum_i(sp); if (lane == 0) { tt[wave] = st; tt[8 + wave] = sp; } }
    __syncthreads();
    int run = 0;
    if (lane < 8) { int base = 0;
#pragma unroll
        for (int e2 = 0; e2 < 8; ++e2) if (e2 < lane) base += ((tt[e2] + 255) >> 8) << 8;
        run = base + tt[8 + lane];
        for (int w2 = 0; w2 < wave; ++w2) run += wcnt[(vcu * NWAVES + w2) * 8 + lane]; }
    if (vcu == 0 && tid < 8) ((int*)(ws + WS_SMALL + SM_ETOT))[tid] = tt[tid];
    const int NGW = G * NWAVES, gw = vcu * NWAVES + wave, RPW = (M + NGW - 1) / NGW;
    for (int ib = 0; ib < RPW; ib += 4) {
        int te4[4]; v4u v4[4][2];
#pragma unroll
        for (int k = 0; k < 4; ++k) { const int rc = min(gw * RPW + ib + k, M - 1); te4[k] = tok_e[rc]; const v4u* s = (const v4u*)(hn + (size_t)rc * DM) + lane; v4[k][0] = s[0]; v4[k][1] = s[64]; }
#pragma unroll
        for (int k = 0; k < 4; ++k) {
            const int row = gw * RPW + ib + k; if (ib + k >= RPW || row >= M) break;
            const int i0 = te4[k] & 0xff, i1 = te4[k] >> 8;
            const int p0 = __shfl(run, i0); if (lane == i0) ++run;
            const int p1 = __shfl(run, i1); if (lane == i1) ++run;
            if (lane == 0) { pos[2 * row] = p0; pos[2 * row + 1] = p1; }
            v4u* d0 = (v4u*)(xp + (size_t)p0 * DM) + lane; v4u* d1 = (v4u*)(xp + (size_t)p1 * DM) + lane;
            d0[0] = v4[k][0]; d1[0] = v4[k][0]; d0[64] = v4[k][1]; d1[64] = v4[k][1];
        }
    }
    __syncthreads();
}

static __device__ __noinline__ void combine_phase(LAS unsigned char* lds, int lane, int wave, int vcu, int G) {
    unsigned char* ws = ARGWS_G(); const float* nw = ARGF_G(I_NFIN); float* out = ARGOUT();
    const float* hA = (const float*)(ws + WS_HA); const bf16* Y = (const bf16*)(ws + WS_Y); const float* YT = (const float*)(ws + WS_YT);
    const int* pos = (const int*)(ws + WS_SMALL + SM_POS); const f32x2* tok_g = (const f32x2*)(ws + WS_SMALL + SM_TOKG); const int* tok_e = (const int*)(ws + WS_SMALL + SM_TOKE);
    const LAS int* stb = (const LAS int*)(lds + SCHED_OFF);
    const int nfull = stb[80], S = stb[81];
    const int NGW = G * NWAVES, gw = vcu * NWAVES + wave;
    int p0n, p1n, ten; f32x2 ggn;
    { const int rc = min(gw, M - 1); p0n = pos[2 * rc]; p1n = pos[2 * rc + 1]; ggn = tok_g[rc]; ten = tok_e[rc]; }
    for (int row = gw; row < M; row += NGW) {
        const int p0 = p0n, p1 = p1n; const f32x2 gg = ggn;
        const int te = ten, e0 = te & 0xff, e1 = te >> 8;
        { const int rc = min(row + NGW, M - 1); p0n = pos[2 * rc]; p1n = pos[2 * rc + 1]; ggn = tok_g[rc]; ten = tok_e[rc]; }
        const int w0b = stb[48 + e0] + (p0 >> 8) - stb[40 + e0], m0 = stb[32 + e0], w1b = stb[48 + e1] + (p1 >> 8) - stb[40 + e1], m1 = stb[32 + e1];
        f32x4 x[8]; v2u ya[8], yb[8]; float ss = 0.f;
#pragma unroll
        for (int j = 0; j < 8; ++j) { const int o = 4 * lane + 256 * j;
            ya[j] = *(const v2u*)(Y + (size_t)p0 * DM + o); yb[j] = *(const v2u*)(Y + (size_t)p1 * DM + o);
            { const v2u t = *(const v2u*)((const bf16*)hA + (size_t)row * DM + o); x[j] = (f32x4){bflo(t.x), bfhi(t.x), bflo(t.y), bfhi(t.y)}; } }
#pragma unroll
        for (int j = 0; j < 8; ++j) {
            f32x4 y0 = (f32x4){bflo(ya[j].x), bfhi(ya[j].x), bflo(ya[j].y), bfhi(ya[j].y)}, y1 = (f32x4){bflo(yb[j].x), bfhi(yb[j].x), bflo(yb[j].y), bfhi(yb[j].y)};
            const int w0 = w0b + j * m0, w1 = w1b + j * m1;
            if (w0 >= nfull) { y0 = (f32x4){0.f, 0.f, 0.f, 0.f}; for (int kp = 0; kp < S; ++kp) y0 += *(const f32x4*)(YT + ((size_t)((w0 - nfull) * S + kp) * 256 + (p0 & 255)) * 256 + 4 * lane); }
            if (w1 >= nfull) { y1 = (f32x4){0.f, 0.f, 0.f, 0.f}; for (int kp = 0; kp < S; ++kp) y1 += *(const f32x4*)(YT + ((size_t)((w1 - nfull) * S + kp) * 256 + (p1 & 255)) * 256 + 4 * lane); }
            x[j] += gg[0] * y0 + gg[1] * y1;
            ss += (x[j][0] * x[j][0] + x[j][1] * x[j][1]) + (x[j][2] * x[j][2] + x[j][3] * x[j][3]); }
        ss = wave_sum(ss);
        const float rstd = 1.0f / sqrtf(ss * (1.0f / DM) + EPS);
#pragma unroll
        for (int j = 0; j < 8; ++j) { const int o = 4 * lane + 256 * j; *(f32x4*)(out + (size_t)row * DM + o) = x[j] * rstd * *(const f32x4*)(nw + o); }
    }
}

static __device__ __noinline__ void kmean_unit(LAS unsigned char* lds, int tid, int u, const bf16* __restrict__ P, float* __restrict__ kmean) {
    const int h = u & 7, blk = (u >> 3) % 7, b = u / 56;
    const bf16* Kp = P + (size_t)(b * SEQ + blk * 256) * NP + PC_K + h * 128;
    const int c = tid & 15, rg = tid >> 4;
    float s[8];
#pragma unroll
    for (int e = 0; e < 8; ++e) s[e] = 0.f;
#pragma unroll
    for (int r = 0; r < 8; ++r) { const v4u v = *(const v4u*)(Kp + (size_t)(rg * 8 + r) * NP + c * 8);
        s[0] += bflo(v.x); s[1] += bfhi(v.x); s[2] += bflo(v.y); s[3] += bfhi(v.y); s[4] += bflo(v.z); s[5] += bfhi(v.z); s[6] += bflo(v.w); s[7] += bfhi(v.w); }
    LAS float* red = (LAS float*)lds;
#pragma unroll
    for (int e = 0; e < 8; ++e) red[rg * 128 + c * 8 + e] = s[e];
    __syncthreads();
    if (tid < 128) { float t = 0.f;
#pragma unroll 8
        for (int r = 0; r < 32; ++r) t += red[r * 128 + tid];
        kmean[(size_t)((b * 8 + h) * 8 + blk) * 128 + tid] = t * (1.0f / 256.0f); }
    __syncthreads();
}

template <int NT>
__device__ __forceinline__ void conv_load(const bf16* __restrict__ Pc, int t0, int seqpos0, const float* __restrict__ cw, const float* __restrict__ cb, unsigned (&raw)[NT + 3], f32x2 (&w)[4], f32x2& bb) {
#pragma unroll
    for (int j = 0; j < 4; ++j) w[j] = *(const f32x2*)(cw + j * 1024);
    bb = *(const f32x2*)cb;
#pragma unroll
    for (int i = 0; i < NT + 3; ++i) { const int t = t0 - 3 + i; const bool ok = seqpos0 + t >= 0; const unsigned v = *(const unsigned*)(Pc + (ptrdiff_t)(ok ? t : -seqpos0) * NP); raw[i] = ok ? v : 0u; }
}
template <int NT>
__device__ __forceinline__ void conv_apply(const unsigned (&raw)[NT + 3], const f32x2 (&w)[4], const f32x2 bb, float (&o0)[NT], float (&o1)[NT]) {
#pragma unroll
    for (int i = 0; i < NT; ++i) { float a0 = bb[0], a1 = bb[1];
#pragma unroll
        for (int j = 0; j < 4; ++j) { a0 += w[j][0] * bflo(raw[i + j]); a1 += w[j][1] * bfhi(raw[i + j]); }
        o0[i] = siluf_(a0); o1[i] = siluf_(a1); }
}

static __device__ __noinline__ void ssd1_unit(LAS unsigned char* lds, int tid, int lane, int wave, int u, int layer) {
    unsigned char* ws = ARGWS_G(); const float* scw = ARGF_G(I_SCW) + (size_t)layer * 4096; const float* scb = ARGF_G(I_SCB) + layer * 1024;
    const int h = u & 7, c = (u >> 3) & 15, b = u >> 7, g = h >> 2;
    const int row0 = b * SEQ + c * 128;
    const bf16* P = (const bf16*)(ws + WS_P); float* XC = (float*)(ws + WS_XC);
    const float* DT = (const float*)(ws + WS_SMALL + SM_DT); float* LAC = (float*)(ws + WS_SMALL + SM_LAC); float* DEC = (float*)(ws + WS_SMALL + SM_DEC); float* ST = (float*)(ws + WS_ST);
    LAS float* wgl = (LAS float*)lds;
    LAS unsigned char* xT = lds + 2048;
    LAS unsigned char* BT = xT + 17408;
    const bool doC = (h & 3) == 1;
    const int cpx = tid & 31, runx = tid >> 5, chx = h * 64 + 2 * cpx, t0x = runx * 8;
    const int cpb = tid & 63, runb = tid >> 6, chb = 512 + g * 128 + 2 * cpb, t0b = runb * 16;
    const int chc = 768 + g * 128 + 2 * cpb;
    unsigned rx[11], rb[19], rc[19]; f32x2 wx[4], wb[4], wc4[4]; f32x2 bx2, bb2, bc2;
    conv_load<8>(P + (size_t)row0 * NP + PC_X + chx, t0x, c * 128, scw + chx, scb + chx, rx, wx, bx2);
    conv_load<16>(P + (size_t)row0 * NP + PC_X + chb, t0b, c * 128, scw + chb, scb + chb, rb, wb, bb2);
    if (doC) conv_load<16>(P + (size_t)row0 * NP + PC_X + chc, t0b, c * 128, scw + chc, scb + chc, rc, wc4, bc2);
    if (wave == 0) {
        const float a = -expf(ARGF_G(I_SALOG)[layer * 8 + h]);
        const float d0 = DT[(size_t)(row0 + 2 * lane) * 8 + h], d1 = DT[(size_t)(row0 + 2 * lane + 1) * 8 + h];
        const float l0 = d0 * a, l1 = d1 * a;
        float sc = l0 + l1;
#pragma unroll
        for (int o = 1; o < 64; o <<= 1) { const float t = __shfl_up(sc, o); if (lane >= o) sc += t; }
        const float c1 = sc, c0 = sc - l1, tot = __shfl(sc, 63);
        wgl[2 * lane] = d0 * expf(tot - c0); wgl[2 * lane + 1] = d1 * expf(tot - c1);
        LAC[(size_t)(row0 + 2 * lane) * 8 + h] = c0; LAC[(size_t)(row0 + 2 * lane + 1) * 8 + h] = c1;
        if (lane == 0) DEC[(b * 16 + c) * 8 + h] = expf(tot);
    }
    __syncthreads();
    {
        float o0[8], o1[8];
        conv_apply<8>(rx, wx, bx2, o0, o1);
#pragma unroll
        for (int i = 0; i < 8; ++i) { const int t = t0x + i; *(unsigned*)((bf16*)XC + (size_t)(row0 + t) * 1024 + chx) = pk2(o0[i], o1[i]);
            const float wg = wgl[t];
            *(LAS bf16*)(xT + (2 * cpx) * 272 + t * 2) = (bf16)f2bf(o0[i] * wg); *(LAS bf16*)(xT + (2 * cpx + 1) * 272 + t * 2) = (bf16)f2bf(o1[i] * wg); }
    }
    {
        float o0[16], o1[16];
        conv_apply<16>(rb, wb, bb2, o0, o1);
        const bool st = (h & 3) == 0;
#pragma unroll
        for (int i = 0; i < 16; ++i) { const int t = t0b + i; if (st) *(unsigned*)((bf16*)XC + (size_t)(row0 + t) * 1024 + chb) = pk2(o0[i], o1[i]);
            *(LAS bf16*)(BT + (2 * cpb) * 272 + t * 2) = (bf16)f2bf(o0[i]); *(LAS bf16*)(BT + (2 * cpb + 1) * 272 + t * 2) = (bf16)f2bf(o1[i]); }
    }
    if (doC) {
        float o0[16], o1[16];
        conv_apply<16>(rc, wc4, bc2, o0, o1);
#pragma unroll
        for (int i = 0; i < 16; ++i) *(unsigned*)((bf16*)XC + (size_t)(row0 + t0b + i) * 1024 + chc) = pk2(o0[i], o1[i]);
    }
    __syncthreads();
    {
        float* Sp = ST + (size_t)((b * 16 + c) * 8 + h) * 64 * 128;
#pragma unroll
        for (int pt = 0; pt < 4; ++pt) {
            f32x4 acc = {0.f, 0.f, 0.f, 0.f};
            acc = mma_lds<128>(acc, xT + pt * 16 * 272, 272, BT + wave * 16 * 272, 272, lane);
#pragma unroll
            for (int r = 0; r < 4; ++r) Sp[(size_t)(pt * 16 + 4 * (lane >> 4) + r) * 128 + wave * 16 + (lane & 15)] = acc[r];
        }
    }
    __syncthreads();
}

static __device__ __noinline__ void cf_unit(LAS unsigned char* lds, int tid, int lane, int wave, int u, int layer) {
    unsigned char* ws = ARGWS_G(); const float* ccw = ARGF_G(I_CCW) + (size_t)layer * 31 * 512; const float* ccb = ARGF_G(I_CCB) + layer * 512; const float* clw = ARGF_G(I_CLW) + layer * 512; const float* clb = ARGF_G(I_CLB) + layer * 512;
    const bf16* P = (const bf16*)(ws + WS_P); bf16* MIX = (bf16*)(ws + WS_MIX);
    const int row0 = u * 32, tseq0 = row0 & (SEQ - 1), c = tid;
    LAS float* ul = (LAS float*)lds;
    {
        v4u av[8], gv[8];
#pragma unroll
        for (int k = 0; k < 8; ++k) { const int it = tid + 512 * k, i = it >> 6, cg = (it & 63) * 8; const int ri = (tseq0 - 30 + i >= 0) ? (row0 - 30 + i) : row0;
            const bf16* pr = P + (size_t)ri * NP + PC_G + cg; av[k] = (it < 62 * 64) ? *(const v4u*)pr : (v4u){0u, 0u, 0u, 0u}; gv[k] = (it < 62 * 64) ? *(const v4u*)(pr + 512) : (v4u){0u, 0u, 0u, 0u}; }
#pragma unroll
        for (int k = 0; k < 8; ++k) { const int it = tid + 512 * k, i = it >> 6, cg = (it & 63) * 8;
            if (it < 62 * 64) {
                const float z = (tseq0 - 30 + i >= 0) ? 1.0f : 0.0f;
                const f32x4 u0 = (f32x4){bflo(av[k].x) * sigmoidf_(bflo(gv[k].x)), bfhi(av[k].x) * sigmoidf_(bfhi(gv[k].x)), bflo(av[k].y) * sigmoidf_(bflo(gv[k].y)), bfhi(av[k].y) * sigmoidf_(bfhi(gv[k].y))} * z;
                const f32x4 u1 = (f32x4){bflo(av[k].z) * sigmoidf_(bflo(gv[k].z)), bfhi(av[k].z) * sigmoidf_(bfhi(gv[k].z)), bflo(av[k].w) * sigmoidf_(bflo(gv[k].w)), bfhi(av[k].w) * sigmoidf_(bfhi(gv[k].w))} * z;
                *(LAS f32x4*)(ul + i * 512 + cg) = u0; *(LAS f32x4*)(ul + i * 512 + cg + 4) = u1; } }
    }
    float wt[31];
#pragma unroll
    for (int j = 0; j < 31; ++j) wt[j] = ccw[j * 512 + c];
    const float bias = ccb[c];
    __syncthreads();
    float uu[62];
#pragma unroll
    for (int i = 0; i < 62; ++i) uu[i] = ul[i * 512 + c];
    float o[32];
#pragma unroll
    for (int i = 0; i < 32; ++i) o[i] = bias;
#pragma unroll
    for (int j = 0; j < 31; ++j) {
#pragma unroll
        for (int i = 0; i < 32; ++i) o[i] += wt[j] * uu[i + j]; }
    __syncthreads();
    LAS float* ol = (LAS float*)lds;
#pragma unroll
    for (int i = 0; i < 32; ++i) ol[i * 512 + c] = o[i];
    __syncthreads();
    const f32x4 lw0 = *(const f32x4*)(clw + 8 * lane), lw1 = *(const f32x4*)(clw + 8 * lane + 4), lb0 = *(const f32x4*)(clb + 8 * lane), lb1 = *(const f32x4*)(clb + 8 * lane + 4);
#pragma unroll
    for (int tt = 0; tt < 4; ++tt) {
        const int i = 4 * wave + tt;
        const f32x4 a = *(const LAS f32x4*)(ol + i * 512 + 8 * lane), bq = *(const LAS f32x4*)(ol + i * 512 + 8 * lane + 4);
        const float mu = wave_sum((a[0] + a[1]) + (a[2] + a[3]) + (bq[0] + bq[1]) + (bq[2] + bq[3])) * (1.0f / 512.0f);
        const f32x4 da = a - mu, db = bq - mu;
        const float var = wave_sum((da[0] * da[0] + da[1] * da[1]) + (da[2] * da[2] + da[3] * da[3]) + (db[0] * db[0] + db[1] * db[1]) + (db[2] * db[2] + db[3] * db[3])) * (1.0f / 512.0f);
        const float rstd = 1.0f / sqrtf(var + EPS);
        const f32x4 ha = da * rstd * lw0 + lb0, hb = db * rstd * lw1 + lb1;
        v4u w; w.x = pk2(siluf_(ha[0]), siluf_(ha[1])); w.y = pk2(siluf_(ha[2]), siluf_(ha[3])); w.z = pk2(siluf_(hb[0]), siluf_(hb[1])); w.w = pk2(siluf_(hb[2]), siluf_(hb[3]));
        *(v4u*)(MIX + (size_t)(row0 + i) * DM + 1536 + 8 * lane) = w;
    }
    __syncthreads();
}

__device__ __forceinline__ void ssd_scan(LAS unsigned char* lds, int tid, int vcu, int G) {
    unsigned char* ws = ARGWS_G();
    const float* ST = (const float*)(ws + WS_ST); const float* DEC = (const float*)(ws + WS_SMALL + SM_DEC); bf16* PREV = (bf16*)(ws + WS_ACT);
    for (int item = vcu; item < 256; item += G) {
        const int b = item >> 6, head = (item >> 3) & 7, pc = item & 7;
        if (tid < 256) {
            const int p = pc * 8 + (tid >> 5), n0 = (tid & 31) * 4;
            f32x4 st[16]; float dec[16];
#pragma unroll
            for (int c = 0; c < 16; ++c) { st[c] = *(const f32x4*)(ST + ((size_t)((b * 16 + c) * 8 + head) * 64 + p) * 128 + n0); dec[c] = DEC[(b * 16 + c) * 8 + head]; }
            f32x4 sacc = {0.f, 0.f, 0.f, 0.f};
#pragma unroll
            for (int c = 0; c < 16; ++c) { v2u w; w.x = pk2(sacc[0], sacc[1]); w.y = pk2(sacc[2], sacc[3]);
                *(v2u*)(PREV + ((size_t)((b * 16 + c) * 8 + head) * 64 + p) * 128 + n0) = w; sacc = sacc * dec[c] + st[c]; }
        }
    }
}

static __device__ __noinline__ void ssd2_part1(LAS unsigned char* lds, int tid, int lane, int wave, int u, int layer) {
    unsigned char* ws = ARGWS_G(); const float* sdp = ARGF_G(I_SD) + layer * 8; const float* snw = ARGF_G(I_SNW) + layer * 512;
    const int half = u & 1, g = (u >> 1) & 1, c = (u >> 2) & 15, b = u >> 6;
    const int row0 = b * SEQ + c * 128, tb = half * 64, SL = tb + 64;
    const bf16* P = (const bf16*)(ws + WS_P); bf16* MIX = (bf16*)(ws + WS_MIX); const float* XC = (const float*)(ws + WS_XC); float* YZ = (float*)(ws + WS_YZ);
    const float* DT = (const float*)(ws + WS_SMALL + SM_DT); const float* LAC = (const float*)(ws + WS_SMALL + SM_LAC); const bf16* PREV = (const bf16*)(ws + WS_ACT);
    LAS unsigned char* Cb = lds;
    LAS unsigned char* Bb = lds + 17408;
    LAS unsigned char* xsT = Bb;
    LAS unsigned char* prv = Bb + 17408;
    LAS float* Gf = (LAS float*)(lds + 52224);
    LAS unsigned char* Mh = lds + 85248;
    LAS float* dts = (LAS float*)(lds + 102656);
    LAS float* lcs = (LAS float*)(lds + 104704);
    LAS float* ssq = (LAS float*)(lds + 106752);
    const int q16 = lane & 15, gq = lane >> 4;
    {
        const int rr = tid >> 3, n0 = (tid & 7) * 16;
        v4u lc[2], lb0[2], lb1[2];
        { const bf16* src = (const bf16*)XC + (size_t)(row0 + tb + rr) * 1024 + 768 + g * 128 + n0;
          lc[0] = *(const v4u*)src; lc[1] = *(const v4u*)(src + 8); }
        { const bf16* src = (const bf16*)XC + (size_t)(row0 + rr) * 1024 + 512 + g * 128 + n0;
          lb0[0] = *(const v4u*)src; lb0[1] = *(const v4u*)(src + 8); lb1[0] = *(const v4u*)(src + (size_t)64 * 1024); lb1[1] = *(const v4u*)(src + (size_t)64 * 1024 + 8); }
        const float ldt = DT[(size_t)(row0 + (tid >> 2)) * 8 + g * 4 + (tid & 3)], llc = LAC[(size_t)(row0 + (tid >> 2)) * 8 + g * 4 + (tid & 3)];
        *(LAS v4u*)(Cb + rr * 272 + n0 * 2) = lc[0]; *(LAS v4u*)(Cb + rr * 272 + n0 * 2 + 16) = lc[1];
        *(LAS v4u*)(Bb + rr * 272 + n0 * 2) = lb0[0]; *(LAS v4u*)(Bb + rr * 272 + n0 * 2 + 16) = lb0[1];
        if (SL > 64) { *(LAS v4u*)(Bb + (rr + 64) * 272 + n0 * 2) = lb1[0]; *(LAS v4u*)(Bb + (rr + 64) * 272 + n0 * 2 + 16) = lb1[1]; }
        if (tid < SL * 4) { dts[tid] = ldt; lcs[tid] = llc; }
        if (tid < 64) ssq[tid] = 0.f;
    }
    __syncthreads();
    if (16 * wave < SL) {
#pragma unroll
        for (int tt = 0; tt < 4; ++tt) { f32x4 acc = {0.f, 0.f, 0.f, 0.f};
            acc = mma_lds<128>(acc, Cb + tt * 16 * 272, 272, Bb + wave * 16 * 272, 272, lane);
#pragma unroll
            for (int r = 0; r < 4; ++r) Gf[(tt * 16 + 4 * gq + r) * 129 + 16 * wave + q16] = acc[r]; }
    }
    __syncthreads();
}
static __device__ __noinline__ void ssd2_head(LAS unsigned char* lds, int tid, int lane, int wave, int u, int layer, int hh) {
    unsigned char* ws = ARGWS(); const float* sdp = ARGF(I_SD) + layer * 8; const float* snw = ARGF(I_SNW) + layer * 512;
    const int half = u & 1, g = (u >> 1) & 1, c = (u >> 2) & 15, b = u >> 6;
    const int row0 = b * SEQ + c * 128, tb = half * 64, SL = tb + 64;
    const bf16* P = (const bf16*)(ws + WS_P); bf16* MIX = (bf16*)(ws + WS_MIX); const float* XC = (const float*)(ws + WS_XC); float* YZ = (float*)(ws + WS_YZ);
    const float* DT = (const float*)(ws + WS_SMALL + SM_DT); const float* LAC = (const float*)(ws + WS_SMALL + SM_LAC); const bf16* PREV = (const bf16*)(ws + WS_ACT);
    LAS unsigned char* Cb = lds;
    LAS unsigned char* Bb = lds + 17408;
    LAS unsigned char* xsT = Bb;
    LAS unsigned char* prv = Bb + 17408;
    LAS float* Gf = (LAS float*)(lds + 52224);
    LAS unsigned char* Mh = lds + 85248;
    LAS float* dts = (LAS float*)(lds + 102656);
    LAS float* lcs = (LAS float*)(lds + 104704);
    LAS float* ssq = (LAS float*)(lds + 106752);
    const int q16 = lane & 15, gq = lane >> 4;
    float ssl[4] = {0.f, 0.f, 0.f, 0.f};
    const int tw = wave >> 1;
        const int head = g * 4 + hh;
        const int pq_ = tid >> 3, nq_ = (tid & 7) * 16;
        const bf16* sp_ = PREV + ((size_t)((b * 16 + c) * 8 + head) * 64 + pq_) * 128 + nq_;
        const v4u pw0 = *(const v4u*)sp_, pw1 = *(const v4u*)(sp_ + 8);
        const int sx_ = tid >> 2, px_ = (tid & 3) * 16, sxc_ = sx_ < SL ? sx_ : SL - 1;
        const bf16* xsrc_ = (const bf16*)XC + (size_t)(row0 + sxc_) * 1024 + head * 64 + px_;
        const v4u xq0_ = *(const v4u*)xsrc_, xq1_ = *(const v4u*)(xsrc_ + 8);
        const float Dh = sdp[head];
        float xv_[2][4]; unsigned zw_[2][4];
#pragma unroll
        for (int q2 = 0; q2 < 2; ++q2)
#pragma unroll
            for (int r = 0; r < 4; ++r) { const int tl = tb + (wave >> 1) * 16 + 4 * gq + r, p = (2 * (wave & 1) + q2) * 16 + q16;
                xv_[q2][r] = bf2f(((const bf16*)XC)[(size_t)(row0 + tl) * 1024 + head * 64 + p]); zw_[q2][r] = P[(size_t)(row0 + tl) * NP + PC_Z + head * 64 + p]; }
        *(LAS v4u*)(prv + pq_ * 272 + nq_ * 2) = pw0; *(LAS v4u*)(prv + pq_ * 272 + nq_ * 2 + 16) = pw1;
        if (sx_ < SL) {
#pragma unroll
            for (int q = 0; q < 8; ++q) { const unsigned wq = q < 4 ? (q == 0 ? xq0_.x : q == 1 ? xq0_.y : q == 2 ? xq0_.z : xq0_.w) : (q == 4 ? xq1_.x : q == 5 ? xq1_.y : q == 6 ? xq1_.z : xq1_.w);
                *(LAS bf16*)(xsT + (px_ + 2 * q) * 272 + sx_ * 2) = (bf16)(wq & 0xffffu); *(LAS bf16*)(xsT + (px_ + 2 * q + 1) * 272 + sx_ * 2) = (bf16)(wq >> 16); } }
        {
            const int t = tid >> 3, s0 = (tid & 7) * 16;
            if (s0 < SL) { const float lt = lcs[(tb + t) * 4 + hh]; unsigned w[8];
                float gv[16], lv[16], dv[16];
#pragma unroll
                for (int q = 0; q < 16; ++q) { gv[q] = Gf[t * 129 + s0 + q]; lv[q] = lcs[(s0 + q) * 4 + hh]; dv[q] = dts[(s0 + q) * 4 + hh]; }
#pragma unroll
                for (int q = 0; q < 8; ++q) { float v2[2];
#pragma unroll
                    for (int e = 0; e < 2; ++e) { const int s = s0 + 2 * q + e; const float val = gv[2 * q + e] * fexp(fminf(lt - lv[2 * q + e], 0.f)) * dv[2 * q + e]; v2[e] = (s <= tb + t) ? val : 0.f; }
                    w[q] = pk2(v2[0], v2[1]); }
                v4u w0, w1; w0.x = w[0]; w0.y = w[1]; w0.z = w[2]; w0.w = w[3]; w1.x = w[4]; w1.y = w[5]; w1.z = w[6]; w1.w = w[7];
                *(LAS v4u*)(Mh + t * 272 + s0 * 2) = w0; *(LAS v4u*)(Mh + t * 272 + s0 * 2 + 16) = w1; }
        }
        __syncthreads();
#pragma unroll
        for (int q2 = 0; q2 < 2; ++q2) {
            const int pp = 2 * (wave & 1) + q2;
            f32x4 yd = {0.f, 0.f, 0.f, 0.f}, yo = {0.f, 0.f, 0.f, 0.f};
            if (half) yd = mma_lds<128>(yd, Mh + tw * 16 * 272, 272, xsT + pp * 16 * 272, 272, lane);
            else yd = mma_lds<64>(yd, Mh + tw * 16 * 272, 272, xsT + pp * 16 * 272, 272, lane);
            yo = mma_lds<128>(yo, Cb + tw * 16 * 272, 272, prv + pp * 16 * 272, 272, lane);
#pragma unroll
            for (int r = 0; r < 4; ++r) {
                const int tl = tb + tw * 16 + 4 * gq + r, p = pp * 16 + q16;
                const float e = fexp(lcs[tl * 4 + hh]), xv = xv_[q2][r];
                const float y = yd[r] + e * yo[r] + Dh * xv;
                const float z = bf2f(zw_[q2][r]);
                const float v = y * siluf_(z);
                ssl[r] += v * v;
                YZ[(size_t)(row0 + tl) * 512 + head * 64 + p] = v;
            }
        }
        __syncthreads();
    LAS float* ssp = (LAS float*)(lds + 107008);
#pragma unroll
    for (int r = 0; r < 4; ++r) { float s = row16_sum(ssl[r]);
        if (q16 == 0) ssp[(hh * 2 + (wave & 1)) * 64 + tw * 16 + 4 * gq + r] = s; }
}
static __device__ __noinline__ void ssd2_finish(LAS unsigned char* lds, int tid, int lane, int wave, int u, int layer) {
    unsigned char* ws = ARGWS_G(); const float* sdp = ARGF_G(I_SD) + layer * 8; const float* snw = ARGF_G(I_SNW) + layer * 512;
    const int half = u & 1, g = (u >> 1) & 1, c = (u >> 2) & 15, b = u >> 6;
    const int row0 = b * SEQ + c * 128, tb = half * 64, SL = tb + 64;
    const bf16* P = (const bf16*)(ws + WS_P); bf16* MIX = (bf16*)(ws + WS_MIX); const float* XC = (const float*)(ws + WS_XC); float* YZ = (float*)(ws + WS_YZ);
    const float* DT = (const float*)(ws + WS_SMALL + SM_DT); const float* LAC = (const float*)(ws + WS_SMALL + SM_LAC); const bf16* PREV = (const bf16*)(ws + WS_ACT);
    LAS unsigned char* Cb = lds;
    LAS unsigned char* Bb = lds + 17408;
    LAS unsigned char* xsT = Bb;
    LAS unsigned char* prv = Bb + 17408;
    LAS float* Gf = (LAS float*)(lds + 52224);
    LAS unsigned char* Mh = lds + 85248;
    LAS float* dts = (LAS float*)(lds + 102656);
    LAS float* lcs = (LAS float*)(lds + 104704);
    LAS float* ssq = (LAS float*)(lds + 106752);
    const int q16 = lane & 15, gq = lane >> 4;
    const int tw = wave >> 1;
    const LAS float* ssp = (const LAS float*)(lds + 107008);
    __syncthreads();
    float vz[4][4][2], sw[4][2];
#pragma unroll
    for (int hh = 0; hh < 4; ++hh)
#pragma unroll
        for (int q2 = 0; q2 < 2; ++q2) { const int ch = g * 256 + hh * 64 + (2 * (wave & 1) + q2) * 16 + q16; sw[hh][q2] = snw[ch];
#pragma unroll
            for (int r = 0; r < 4; ++r) vz[hh][r][q2] = YZ[(size_t)(row0 + tb + tw * 16 + 4 * gq + r) * 512 + ch]; }
#pragma unroll
    for (int r = 0; r < 4; ++r) {
        const int t = tw * 16 + 4 * gq + r; float sq = 0.f;
#pragma unroll
        for (int k = 0; k < 8; ++k) sq += ssp[k * 64 + t];
        const float rstd = 1.0f / sqrtf(sq * (1.0f / 256.0f) + EPS);
#pragma unroll
        for (int hh = 0; hh < 4; ++hh)
#pragma unroll
            for (int q2 = 0; q2 < 2; ++q2) { const int ch = g * 256 + hh * 64 + (2 * (wave & 1) + q2) * 16 + q16;
                MIX[(size_t)(row0 + tb + t) * DM + 1024 + ch] = (bf16)f2bf(vz[hh][r][q2] * rstd * sw[hh][q2]); }
    }
    __syncthreads();
}

__device__ __forceinline__ void attn_tile(LAS unsigned char* lds, int tid, int lane, int wave, int b, int h, int t) {
    asm volatile("" : "+v"(tid), "+v"(lane));
    unsigned char* ws = (unsigned char*)ldarg_g(lds, 24);
    const bf16* P = (const bf16*)(ws + WS_P); bf16* MIX = (bf16*)(ws + WS_MIX); const float* kmean = (const float*)(ws + WS_SMALL + SM_KMEAN);
    const int i = t >> 1, hf = t & 1, q16 = lane & 15, gq = lane >> 4;
    const int qi = hf * 128 + 16 * wave + q16;
    const size_t qrow = (size_t)b * SEQ + i * 256 + qi;
    LAS float* kml = (LAS float*)(lds + 71680);
    for (int x = tid; x < 7 * 128; x += 512) kml[x] = kmean[(size_t)((b * 8 + h) * 8) * 128 + x];
    bf16x8 Qf[4];
#pragma unroll
    for (int ks = 0; ks < 4; ++ks) Qf[ks] = *(const bf16x8*)(P + qrow * NP + PC_Q + h * 128 + 32 * ks + 8 * gq);
    const int n_own = hf ? 4 : 2, n_it = n_own + 4 * i;
    v4u pk[2], pv[2];
#define TILE_ROWS(it) ((size_t)b * SEQ + ((it) < n_own ? i : (((it) - n_own) >> 2)) * 256 + ((it) < n_own ? (it) : (((it) - n_own) & 3)) * 64)
    {
        const size_t kr = TILE_ROWS(0);
#pragma unroll
        for (int e = 0; e < 2; ++e) { const int x = tid + 512 * e, key = x >> 4, c16 = x & 15; const bf16* src = P + (kr + key) * NP + h * 128 + c16 * 8; pk[e] = *(const v4u*)(src + PC_K); pv[e] = *(const v4u*)(src + PC_V); }
    }
    __syncthreads();
    unsigned sel;
    if (i <= 3) sel = (1u << i) - 1u;
    else {
        float gate[7];
#pragma unroll
        for (int j = 0; j < 7; ++j) { float s = 0.f;
            if (j < i) {
#pragma unroll
                for (int ks = 0; ks < 4; ++ks) { const f32x4 ka = *(const LAS f32x4*)(kml + j * 128 + 32 * ks + 8 * gq), kb = *(const LAS f32x4*)(kml + j * 128 + 32 * ks + 8 * gq + 4);
                    const bf16x8 qv = Qf[ks];
                    s += bf2f((unsigned short)qv[0]) * ka[0] + bf2f((unsigned short)qv[1]) * ka[1] + bf2f((unsigned short)qv[2]) * ka[2] + bf2f((unsigned short)qv[3]) * ka[3]
                       + bf2f((unsigned short)qv[4]) * kb[0] + bf2f((unsigned short)qv[5]) * kb[1] + bf2f((unsigned short)qv[6]) * kb[2] + bf2f((unsigned short)qv[7]) * kb[3]; }
            }
            s = xrow_sum(s); gate[j] = s; }
        sel = 0u;
#pragma unroll
        for (int rep = 0; rep < 3; ++rep) { float best = -INFINITY; int bj = 0;
#pragma unroll
            for (int j = 0; j < 7; ++j) if (j < i && !((sel >> j) & 1u) && gate[j] > best) { best = gate[j]; bj = j; }
            sel |= 1u << bj; }
    }
    {
#pragma unroll
        for (int e = 0; e < 2; ++e) { const int x = tid + 512 * e, key = x >> 4, c16 = x & 15; *(LAS v4u*)(lds + key * 272 + c16 * 16) = pk[e]; *(LAS v4u*)(lds + 17408 + key * 288 + c16 * 16) = pv[e]; }
    }
    __syncthreads();
    f32x4 O[8];
#pragma unroll
    for (int d = 0; d < 8; ++d) O[d] = (f32x4){0.f, 0.f, 0.f, 0.f};
    float mrun = -1e30f, lrun = 0.f;
    v4u pk1[2], pv1[2];
#define ATT_LOAD(PK, PV, TILE) do { const size_t kr_ = TILE_ROWS(TILE); _Pragma("unroll") for (int e = 0; e < 2; ++e) { const int x = tid + 512 * e, key = x >> 4, c16 = x & 15; \
        const bf16* src = P + (kr_ + key) * NP + h * 128 + c16 * 8; PK[e] = *(const v4u*)(src + PC_K); PV[e] = *(const v4u*)(src + PC_V); } } while (0)
#define ATT_STORE(PK, PV, BUF) do { LAS unsigned char* Kn_ = lds + (BUF) * 35840; _Pragma("unroll") for (int e = 0; e < 2; ++e) { const int x = tid + 512 * e, key = x >> 4, c16 = x & 15; \
        *(LAS v4u*)(Kn_ + key * 272 + c16 * 16) = PK[e]; *(LAS v4u*)(Kn_ + 17408 + key * 288 + c16 * 16) = PV[e]; } } while (0)
    if (n_it > 1) ATT_LOAD(pk1, pv1, 1);
#pragma unroll 1
    for (int it0 = 0; it0 < n_it; it0 += 2) {
#pragma unroll
      for (int par = 0; par < 2; ++par) {
        const int it = it0 + par, buf = par;
        if (it + 2 < n_it) { if (par == 0) ATT_LOAD(pk, pv, it + 2); else ATT_LOAD(pk1, pv1, it + 2); }
        const bool own = it < n_own; const int blk = own ? i : ((it - n_own) >> 2), kt = own ? it : ((it - n_own) & 3);
        const bool skip = own && (kt * 64 > hf * 128 + 16 * wave + 15);
        if (!skip) {
            const LAS unsigned char* Kl = lds + buf * 35840; const LAS unsigned char* Vl = Kl + 17408;
            f32x4 s[4];
            {
                bf16x8 kf[4][4];
#pragma unroll
                for (int T = 0; T < 4; ++T)
#pragma unroll
                    for (int ks = 0; ks < 4; ++ks) kf[T][ks] = *(const LAS bf16x8*)(Kl + (16 * T + q16) * 272 + ks * 64 + gq * 16);
                __builtin_amdgcn_sched_barrier(0);
#pragma unroll
                for (int T = 0; T < 4; ++T) { s[T] = __builtin_amdgcn_mfma_f32_16x16x32_bf16(kf[T][0], Qf[0], (f32x4){0.f, 0.f, 0.f, 0.f}, 0, 0, 0);
#pragma unroll
                    for (int ks = 1; ks < 4; ++ks) s[T] = __builtin_amdgcn_mfma_f32_16x16x32_bf16(kf[T][ks], Qf[ks], s[T], 0, 0, 0); }
                __builtin_amdgcn_sched_barrier(0);
            }
            if (own) {
#pragma unroll
                for (int T = 0; T < 4; ++T)
#pragma unroll
                    for (int r = 0; r < 4; ++r) if (kt * 64 + 16 * T + 4 * gq + r > qi) s[T][r] = -INFINITY;
            } else {
                const float bias = ((sel >> blk) & 1u) ? 0.f : -INFINITY;
#pragma unroll
                for (int T = 0; T < 4; ++T) s[T] += bias;
            }
            float mx = -INFINITY;
#pragma unroll
            for (int T = 0; T < 4; ++T) mx = fmaxf(mx, fmaxf(fmaxf(s[T][0], s[T][1]), fmaxf(s[T][2], s[T][3])));
            mx = xrow_max(mx);
            const float mnew = fmaxf(mrun, mx), alpha = __builtin_amdgcn_exp2f(mrun - mnew);
            mrun = mnew;
            float rs = 0.f;
#pragma unroll
            for (int T = 0; T < 4; ++T)
#pragma unroll
                for (int r = 0; r < 4; ++r) { const float p = __builtin_amdgcn_exp2f(s[T][r] - mnew); s[T][r] = p; rs += p; }
            rs = xrow_sum(rs);
            lrun = lrun * alpha + rs;
#pragma unroll
            for (int d = 0; d < 8; ++d) O[d] *= alpha;
#pragma unroll
            for (int k2 = 0; k2 < 2; ++k2) {
                bf16x8 pb; { const unsigned w0 = pg8::cvt_pk_bf16(s[2 * k2][0], s[2 * k2][1]), w1 = pg8::cvt_pk_bf16(s[2 * k2][2], s[2 * k2][3]), w2 = pg8::cvt_pk_bf16(s[2 * k2 + 1][0], s[2 * k2 + 1][1]), w3 = pg8::cvt_pk_bf16(s[2 * k2 + 1][2], s[2 * k2 + 1][3]);
                    const v4u wv = {w0, w1, w2, w3}; pb = __builtin_bit_cast(bf16x8, wv); }
                s16x4 v0[8], v1[8];
#pragma unroll
                for (int d = 0; d < 8; ++d) {
                    const LAS unsigned char* va0 = Vl + (32 * k2 + 4 * gq + (q16 >> 2)) * 288 + (16 * d + 4 * (q16 & 3)) * 2;
                    v0[d] = __builtin_amdgcn_ds_read_tr16_b64_v4i16((LAS s16x4*)va0);
                    v1[d] = __builtin_amdgcn_ds_read_tr16_b64_v4i16((LAS s16x4*)(va0 + 16 * 288));
                }
                __builtin_amdgcn_sched_barrier(0);
#pragma unroll
                for (int d = 0; d < 8; ++d) {
                    const bf16x8 va = {v0[d][0], v0[d][1], v0[d][2], v0[d][3], v1[d][0], v1[d][1], v1[d][2], v1[d][3]};
                    O[d] = __builtin_amdgcn_mfma_f32_16x16x32_bf16(va, pb, O[d], 0, 0, 0);
                }
                __builtin_amdgcn_sched_barrier(0);
            }
        }
        if (it + 1 < n_it) { if (par == 0) ATT_STORE(pk1, pv1, 1); else ATT_STORE(pk, pv, 0); }
        __syncthreads();
      }
    }
#undef ATT_LOAD
#undef ATT_STORE
    const float inv = 1.0f / lrun;
#pragma unroll
    for (int d = 0; d < 8; ++d) { v2u w; w.x = pk2(O[d][0] * inv, O[d][1] * inv); w.y = pk2(O[d][2] * inv, O[d][3] * inv);
        *(v2u*)(MIX + qrow * DM + h * 128 + 16 * d + 4 * gq) = w; }
    __syncthreads();
}

template <class Sched>
__device__ __forceinline__ void rs_table(LAS unsigned char* lds, unsigned char* ws, const Sched& S, int tid) {
    volatile LAS int* pml = (volatile LAS int*)(lds + RS_OFF - 32);
    if (tid == 0) { int n = 0; for (int k = 0; k < 8; ++k) pml[k] = -1; pg8::Unit uu;
        volatile LAS int* smap = (volatile LAS int*)(lds + RS_OFF - 32 - 128);
        for (int i = 0; S.next(i, uu); ++i) { bool f = false; for (int k = 0; k < n; ++k) f |= (pml[k] == uu.pm); if (!f && n < 8) { pml[n] = uu.pm; smap[uu.pm] = n; ++n; } } }
    __syncthreads();
    const float* ssp = (const float*)(ws + WS_SMALL + SM_SS); LAS float* rst = (LAS float*)(lds + RS_OFF);
#pragma unroll
    for (int hb = 0; hb < 8; hb += 4) {
        if (hb && pml[4] < 0) break;
        int pmv[4]; f32x4 av[4][4];
#pragma unroll
        for (int sl = 0; sl < 4; ++sl) { pmv[sl] = pml[hb + sl]; const int row = tid >> 1, hf = tid & 1;
            const GAS f32x4* p4 = (const GAS f32x4*)((const GAS float*)ssp + ((size_t)(max(pmv[sl], 0) * 256 + row) * 32 + hf * 16));
#pragma unroll
            for (int q = 0; q < 4; ++q) av[sl][q] = p4[q]; }
#pragma unroll
        for (int sl = 0; sl < 4; ++sl) { const int row = tid >> 1, hf = tid & 1;
            const f32x4 a0 = av[sl][0], a1 = av[sl][1], a2 = av[sl][2], a3 = av[sl][3];
            float sacc = ((a0[0] + a0[1]) + (a0[2] + a0[3])) + ((a1[0] + a1[1]) + (a1[2] + a1[3])) + ((a2[0] + a2[1]) + (a2[2] + a2[3])) + ((a3[0] + a3[1]) + (a3[2] + a3[3]));
            sacc += __shfl_xor(sacc, 1);
            if (hf == 0 && pmv[sl] >= 0) rst[(hb + sl) * 256 + row] = 1.0f / sqrtf(sacc * (1.0f / DM) + EPS); }
    }
    __syncthreads();
}

__global__ void __launch_bounds__(NWAVES * 64, 2) fwd_kernel(Args args) {
    extern __shared__ __attribute__((aligned(16))) unsigned char lds_raw[];
    LAS unsigned char* lds = (LAS unsigned char*)lds_raw;
    const int tid = threadIdx.x, lane = tid & 63, wave = __builtin_amdgcn_readfirstlane(tid >> 6);
    const int G = gridDim.x; const int bx = blockIdx.x; const int vcu = (G % 8 == 0) ? (bx % 8) * (G / 8) + bx / 8 : bx;
    volatile LAS unsigned* MISC = (volatile LAS unsigned*)(lds + MISC_OFF);
    for (int u = tid; u < (LDS_BYTES - MISC_OFF) / 4; u += NWAVES * 64) ((LAS unsigned*)(lds + MISC_OFF))[u] = 0u;
    __syncthreads();
    if (tid == 0) {
        LAS unsigned long long* at = (LAS unsigned long long*)(lds + ARGS_OFF);
#pragma unroll
        for (int k = 0; k < 23; ++k) at[k] = (unsigned long long)args.in[k];
        at[23] = (unsigned long long)args.out; at[24] = (unsigned long long)args.ws;
    }
    __syncthreads();
    static_assert(WS_CTL == 0 && CW_BAR == 4096 && MISC_OFF == 131072 && ARGS_OFF == 131072 + 1024, "grid_barrier() hard-codes these");
    if (!MK_PER_PHASE) { const XcdBarrier b0 = xcd_barrier_post((unsigned*)(ARGWS() + WS_CTL) + CW_BAR, MISC); if (tid == 0) MISC[2] = b0.x; __syncthreads(); }
    const int lo = args.ph_lo, hi = args.ph_hi;
#define IN(k) (lo <= (k) && (k) < hi)
#define NREP(k) (((PROBE_MASK >> (k)) & 1u) ? 2 : 1)
#define SEAM(k) do { if (!MK_PER_PHASE && IN(k) && ((k) + 1 < hi || rep_ + 1 < NREP(k))) grid_barrier(lds); } while (0)
    volatile LAS int* stb = (volatile LAS int*)(lds + SCHED_OFF);

#pragma unroll 1
    for (int rep_ = 0; rep_ < NREP(0); ++rep_) if (IN(0)) { p0_prologue(lds, tid, lane, wave, vcu, G); __syncthreads(); if (rep_ + 1 < NREP(0)) grid_barrier(lds); }

#pragma unroll 1
    for (int layer = 0; layer < 2; ++layer) {
        const int pb = 1 + 10 * layer;
        const bool moe = (layer & 1) != 0;

#pragma unroll 1
        for (int rep_ = 0; rep_ < NREP(pb + 0); ++rep_) if (layer == 0 && IN(pb + 0)) {
            unsigned char* ws = ARGWS();
            const float* hin = layer == 0 ? ARGF(I_X) : (const float*)(ws + WS_HB);
            norm_phase<0>(lds, tid, lane, wave, vcu, G, hin, ARGF(I_NMIX) + layer * DM, (bf16*)(ws + WS_HN), ARGF(I_WIN) + (size_t)layer * DM * IN_DIM + 4608, IN_DIM,
                          ARGF(I_SDTB) + layer * 8, (float*)(ws + WS_SMALL + SM_DT), nullptr, nullptr, nullptr, nullptr);
            SEAM(pb + 0);
        }
#pragma unroll 1
        for (int rep_ = 0; rep_ < NREP(pb + 1); ++rep_) if (IN(pb + 1)) {
            unsigned char* ws = ARGWS();
            pg8::Gemm g{(const bf16*)(ws + (layer ? WS_HB : WS_HN)), (const bf16*)(ws + WS_WIN) + (size_t)layer * NP * DM, M, NP, DM};     pg8::StaticOrder S; S.init(M, layer ? NP + 256 : NP, G, bx);
            pg8::EpiInproj E{(bf16*)(ws + WS_P), NP, (const float*)(ws + WS_ROPE), 0.08838834764831845f * 1.4426950408889634f, layer ? (const LAS unsigned char*)(lds + RS_OFF) : nullptr};
            if (layer) rs_table(lds, ws, S, tid);
            const bool cvA = ((bx >> 3) & 1) == 0; const int cvw = (((bx >> 4) << 3) | (bx & 7)) * NWAVES + wave;
            const int cvh = ((G >> 4) * 8 + (cvA ? min(G & 15, 8) : max((G & 15) - 8, 0))) * NWAVES;
            constexpr int IT_E1 = IT_IN + (IT_EARLY - IT_IN) / 2;
            if (layer == 0 && rep_ == 0 && cvA) { cv_run(lds, lds + wave * 16384, lane, IT_IN + cvw, cvh, IT_E1); __syncthreads(); }
            pg8::gemm_phase<pg8::EpiInproj, pg8::StaticOrder, true, true>(lds, g, S, E);
            if (layer == 0 && rep_ == 0 && !cvA) { __syncthreads(); cv_run(lds, lds + wave * 16384, lane, IT_E1 + cvw, cvh, IT_EARLY); __syncthreads(); }
            SEAM(pb + 1);
        }
#pragma unroll 1
        for (int rep_ = 0; rep_ < NREP(pb + 2); ++rep_) if (IN(pb + 2)) {
            for (int r2 = 0; r2 < (PROBE_SUB == 3 ? 2 : 1); ++r2)
            for (int u = vcu; u < 224; u += G) kmean_unit(lds, tid, u, (const bf16*)(ARGWS() + WS_P), (float*)(ARGWS() + WS_SMALL + SM_KMEAN));
            for (int r2 = 0; r2 < (PROBE_SUB == 4 ? 2 : 1); ++r2)
            for (int u = vcu; u < 512; u += G) ssd1_unit(lds, tid, lane, wave, u, layer);
            for (int r2 = 0; r2 < (PROBE_SUB == 5 ? 2 : 1); ++r2)
            for (int u = vcu; u < 256; u += G) cf_unit(lds, tid, lane, wave, u, layer);
            SEAM(pb + 2);
        }
#pragma unroll 1
        for (int rep_ = 0; rep_ < NREP(pb + 3); ++rep_) if (IN(pb + 3)) {
            ssd_scan(lds, tid, vcu, G); grid_barrier(lds);
            for (int r2 = 0; r2 < (PROBE_SUB == 1 ? 2 : 1); ++r2)
            for (int u = vcu; u < 256; u += G) { const int b = u >> 6, h = (u >> 3) & 7, pi = u & 7;
#pragma unroll 1
                for (int tt = 0; tt < 2; ++tt) attn_tile(lds, tid, lane, wave, b, h, tt ? 15 - pi : pi); }
            for (int r2 = 0; r2 < (PROBE_SUB == 2 ? 2 : 1); ++r2)
            for (int u = vcu; u < 256; u += G) { ssd2_part1(lds, tid, lane, wave, u, layer); for (int hh = 0; hh < 4; ++hh) ssd2_head(lds, tid, lane, wave, u, layer, hh); ssd2_finish(lds, tid, lane, wave, u, layer); }
            SEAM(pb + 3);
        }
#pragma unroll 1
        for (int rep_ = 0; rep_ < NREP(pb + 4); ++rep_) if (IN(pb + 4)) {
            unsigned char* ws = ARGWS();
            const float* hin = layer == 0 ? ARGF(I_X) : (const float*)(ws + WS_HB);
            pg8::Gemm g{(const bf16*)(ws + WS_MIX), (const bf16*)(ws + WS_WOUT) + (size_t)layer * DM * DM, M, DM, DM}; pg8::StaticOrder S; S.init(M, DM, G, bx);
            pg8::EpiRes E{hin, (float*)(ws + WS_HA), moe ? DM : -DM, 1.0f, nullptr};
            pg8::gemm_phase<pg8::EpiRes, pg8::StaticOrder, false, true>(lds, g, S, E);
            SEAM(pb + 4);
        }
#pragma unroll 1
        for (int rep_ = 0; rep_ < NREP(pb + 5); ++rep_) if (moe && IN(pb + 5)) {
            unsigned char* ws = ARGWS();
            norm_phase<1>(lds, tid, lane, wave, vcu, G, (const float*)(ws + WS_HA), ARGF(I_NFFN) + layer * DM, (bf16*)(ws + WS_HN8), ARGF(I_RT) + (size_t)(layer >> 1) * DM * NE, NE, nullptr, nullptr,
                               (int*)(ws + WS_SMALL + SM_TOKE), (f32x2*)(ws + WS_SMALL + SM_TOKG), (int*)(ws + WS_SMALL + SM_WCNT), (int*)(ws + WS_SMALL + SM_BCNT));
            SEAM(pb + 5);
        }
#pragma unroll 1
        for (int rep_ = 0; rep_ < NREP(pb + 6); ++rep_) if (moe && IN(pb + 6)) { gather_phase(lds, tid, lane, wave, vcu, G); SEAM(pb + 6); }
        if (IN(pb + 7) || IN(pb + 8)) {
            __syncthreads();
            if (tid == 0) {
                if (!moe) { stb[0] = 4; for (int g2 = 0; g2 < 4; ++g2) { stb[32 + g2] = 8; stb[40 + g2] = 8 * g2; } }
                else { const GAS int* et = (const GAS int*)(ARGWS_G() + WS_SMALL + SM_ETOT); typedef int i32x4_ __attribute__((ext_vector_type(4)));
                    const i32x4_ ea = *(const GAS i32x4_*)et, eb = *(const GAS i32x4_*)(et + 4);
                    stb[0] = 8; int mb = 0;
#pragma unroll
                    for (int e = 0; e < 8; ++e) { const int mt = ((e < 4 ? ea[e & 3] : eb[e & 3]) + 255) >> 8; stb[32 + e] = mt; stb[40 + e] = mb; mb += mt; } }
            }
            __syncthreads();
        }
#pragma unroll 1
        for (int rep_ = 0; rep_ < NREP(pb + 7); ++rep_) if (IN(pb + 7)) {
            if (tid == 0) { const int ng = stb[0]; int cum = 0; for (int g2 = 0; g2 < ng; ++g2) { stb[48 + g2] = cum; cum += stb[32 + g2] * 56; stb[64 + g2] = (moe ? g2 : 0) * 56; } stb[48 + ng] = cum; stb[80] = cum; stb[81] = 1; }
            __syncthreads();
            unsigned char* ws = ARGWS();
            pg8::GroupOrder S; S.tb = (const LAS int*)stb; S.G = G; S.c = bx; S.nwg = __builtin_amdgcn_readfirstlane(stb[48 + stb[0]]);
            if (!moe) {
                const bool cvFirst = ((bx >> 3) & 1) == 0; const int half = ((G >> 4) * 8 + (cvFirst ? min(G & 15, 8) : max((G & 15) - 8, 0))) * NWAVES;
                const int cw = (((bx >> 4) << 3) | (bx & 7)) * NWAVES + wave;
                constexpr int IT_MID = IT_EARLY + 4 * IT_FF;
                if (cvFirst && rep_ == 0) { cv_run(lds, lds + wave * 16384, lane, IT_EARLY + cw, half, IT_MID); __syncthreads(); }
                rs_table(lds, ws, S, tid);
                pg8::Gemm g{(const bf16*)(ws + WS_HN8), (const bf16*)(ws + WS_WGU), 0, 0, DM / 2};
                pg8::EpiSwiglu8 E{ws + WS_ACT, DFF, 0.0078125f, 0.0078125f, true, (const LAS unsigned char*)(lds + RS_OFF)};
                pg8::gemm_phase<pg8::EpiSwiglu8, pg8::GroupOrder, true, true, true>(lds, g, S, E);
                if (!cvFirst && rep_ == 0) { __syncthreads(); cv_run(lds, lds + wave * 16384, lane, IT_MID + cw, half, IT_TOTAL); __syncthreads(); }
            } else {
                pg8::Gemm g{(const bf16*)(ws + WS_XP8), (const bf16*)(ws + WS_WGU8), 0, 0, DM / 2};
                pg8::EpiSwiglu8 E{ws + WS_ACT8, DFF, 0.0078125f, 0.0625f, false, nullptr};
                pg8::gemm_phase<pg8::EpiSwiglu8, pg8::GroupOrder, true, true, true>(lds, g, S, E);
            }
            SEAM(pb + 7);
        }
#pragma unroll 1
        for (int rep_ = 0; rep_ < NREP(pb + 8); ++rep_) if (IN(pb + 8)) {
            __syncthreads();
            if (tid == 0) { const int ng = stb[0]; int cum = 0; for (int g2 = 0; g2 < ng; ++g2) { stb[48 + g2] = cum; cum += stb[32 + g2] * 8; stb[64 + g2] = (moe ? g2 : 0) * 8; } stb[48 + ng] = cum;
                const int R = cum % G; int S = 1; if (moe && cum > G && R > 0) { if (4 * R <= G) S = 4; else if (2 * R <= G) S = 2; }
                stb[80] = S > 1 ? cum - R : cum; stb[81] = S; }
            __syncthreads();
            unsigned char* ws = ARGWS();
            pg8::GroupOrder S; S.tb = (const LAS int*)stb; S.G = G; S.c = bx; { const int tot = stb[48 + stb[0]], nf = stb[80]; S.nwg = __builtin_amdgcn_readfirstlane(nf + (tot - nf) * stb[81]); }
            if (!moe) {
                pg8::Gemm g{(const bf16*)(ws + WS_ACT), (const bf16*)(ws + WS_WDN), 0, 0, DFF};
                pg8::EpiRes E{(const float*)(ws + WS_HA), (float*)(ws + WS_HB), -(DM + 1), 1.0f, nullptr};
                pg8::gemm_phase<pg8::EpiRes, pg8::GroupOrder, false, true, false>(lds, g, S, E);
            } else {
                pg8::Gemm g{(const bf16*)(ws + WS_ACT8), (const bf16*)(ws + WS_WDN8), 0, 0, DFF / 2};
                pg8::EpiRes E{nullptr, (float*)(ws + WS_YT), DM, 1.0f / 1024.0f, (bf16*)(ws + WS_Y)};
                pg8::gemm_phase<pg8::EpiRes, pg8::GroupOrder, false, true, true>(lds, g, S, E);
            }
            SEAM(pb + 8);
        }
#pragma unroll 1
        for (int rep_ = 0; rep_ < NREP(pb + 9); ++rep_) if (moe && IN(pb + 9)) { combine_phase(lds, lane, wave, vcu, G); if (rep_ + 1 < NREP(pb + 9)) grid_barrier(lds); }
    }
#undef IN
#undef SEAM
}

extern "C" void kernel_launch(void* const* d_in, const int* in_sizes, int n_in, void* d_out, int out_size, void* d_ws, size_t ws_size, hipStream_t stream) {
    static int grid = 0;
    if (grid == 0) {
        if (n_in != 23 || out_size != M * DM || ws_size < WS_END) { fprintf(stderr, "kernel_launch: unexpected problem (n_in %d, out %d, ws %zu < %zu)\n", n_in, out_size, ws_size, (size_t)WS_END); grid = -1; return; }
        int dev = 0, cus = 0, per_cu = 0;
        if (hipGetDevice(&dev) != hipSuccess || hipDeviceGetAttribute(&cus, hipDeviceAttributeMultiprocessorCount, dev) != hipSuccess) { grid = -1; return; }
        if (hipFuncSetAttribute((const void*)fwd_kernel, hipFuncAttributeMaxDynamicSharedMemorySize, LDS_BYTES) != hipSuccess) { fprintf(stderr, "kernel_launch: hipFuncSetAttribute failed\n"); grid = -1; return; }
        if (hipOccupancyMaxActiveBlocksPerMultiprocessor(&per_cu, (const void*)fwd_kernel, NWAVES * 64, LDS_BYTES) != hipSuccess || per_cu < 1) fprintf(stderr, "kernel_launch: occupancy query reports %d\n", per_cu);
        (void)hipGetLastError();
        grid = cus < 256 ? cus : 256;
    }
    if (grid < 0) return;
    if (hipMemsetAsync((char*)d_ws + WS_CTL, 0, CTL_ZERO_BYTES, stream) != hipSuccess) return;
    Args a{};
    for (int i = 0; i < 23; ++i) a.in[i] = (const float*)d_in[i];
    a.out = (float*)d_out; a.ws = (unsigned char*)d_ws;
#if MK_PER_PHASE
    for (int ph = 0; ph < 21; ++ph) {
        if (ph == 7 || ph == 10) continue;
        a.ph_lo = ph; a.ph_hi = ph + 1;
        hipLaunchKernelGGL(fwd_kernel, dim3(grid), dim3(NWAVES * 64), LDS_BYTES, stream, a);
    }
#else
    a.ph_lo = 0; a.ph_hi = 21;
    hipLaunchKernelGGL(fwd_kernel, dim3(grid), dim3(NWAVES * 64), LDS_BYTES, stream, a);
#endif
}
```
